# Optimizing an MI355X kernel written in HIP

```python
import math
import jax, jax.numpy as jnp
from jax import lax
import numpy as np

D_MODEL = 1024
BATCH = 4
SEQ = 8192
DEPTH = 1

D_MIX = D_MODEL
ATTN_QK_DIM = 32
ATTN_V_DIM = 2 * ATTN_QK_DIM
N_ATTN_HEADS = (D_MIX // 2) // ATTN_V_DIM
W_ATTN_QK = N_ATTN_HEADS * 2 * ATTN_QK_DIM
W_ATTN = N_ATTN_HEADS * ATTN_V_DIM
ROT_DIM = ATTN_QK_DIM // 4
ROPE_THETA = 500000.0
Q_BLOCK = 128
POS_OFFSET_MAX = 1024
S5_GROUP_CH = 16
S5_STATE = 64
W_S5 = D_MIX - W_ATTN
S5_GROUPS = W_S5 // S5_GROUP_CH
S5_MIN_STEP = 1e-3
S5_MAX_STEP = 1e-1
D_IN_PROJ = 2 * W_ATTN_QK + W_ATTN + W_S5
N_EXPERTS = 32
TOP_K = 4
D_FF = D_MODEL
SWIGLU_ALPHA = 1.702
SWIGLU_LIMIT = 7.0
MOE_BLOCK = 128
RMS_EPS = 1e-6

kernel_name = "hybrid_diffattn_s5_moe_block"


def rms_norm(x, w, eps=RMS_EPS):
    xf = x.astype(jnp.float32)
    y = xf * lax.rsqrt(jnp.mean(xf * xf, axis=-1, keepdims=True) + eps)
    return y.astype(x.dtype) * w


def rope_tables(positions):
    inv_freq = ROPE_THETA ** (-jnp.arange(0, ROT_DIM, 2, dtype=jnp.float32) / ROT_DIM)
    ang = positions.astype(jnp.float32)[..., None] * inv_freq
    return jnp.cos(ang), jnp.sin(ang)


def apply_partial_rope(t, cos, sin):
    half = ROT_DIM // 2
    cos = cos[:, :, None, None, :].astype(t.dtype)
    sin = sin[:, :, None, None, :].astype(t.dtype)
    t1 = t[..., :half]
    t2 = t[..., half:ROT_DIM]
    return jnp.concatenate([t1 * cos - t2 * sin, t2 * cos + t1 * sin, t[..., ROT_DIM:]], axis=-1)


def diff_attention(q, k, v, cos, sin, q_norm_w, k_norm_w, lam, subln_w, lambda_init):
    B, S, _ = q.shape
    H, d, dv = N_ATTN_HEADS, ATTN_QK_DIM, ATTN_V_DIM
    q = rms_norm(q.reshape(B, S, H, 2, d), q_norm_w)
    k = rms_norm(k.reshape(B, S, H, 2, d), k_norm_w)
    q = apply_partial_rope(q, cos, sin)
    k = apply_partial_rope(k, cos, sin)
    q = jnp.transpose(q, (0, 2, 3, 1, 4))
    k = jnp.transpose(k, (0, 2, 3, 1, 4))
    v = jnp.transpose(v.reshape(B, S, H, dv), (0, 2, 1, 3))
    n_qb = S // Q_BLOCK
    qb = jnp.moveaxis(q.reshape(B, H, 2, n_qb, Q_BLOCK, d), 3, 0)
    scale = 1.0 / math.sqrt(d)

    def block(q_blk):
        s = jnp.einsum('bhcqd,bhckd->bhcqk', q_blk, k).astype(jnp.float32) * scale
        p = jax.nn.softmax(s, axis=-1)
        a = p[:, :, 0] - lam * p[:, :, 1]
        return jnp.einsum('bhqk,bhkv->bhqv', a.astype(v.dtype), v)

    o = lax.map(block, qb)
    o = jnp.transpose(o, (1, 0, 3, 2, 4)).reshape(B, S, H, dv)
    o = rms_norm(o, subln_w) * (1.0 - lambda_init)
    return o.reshape(B, S, W_ATTN)


def complex_combine(e_i, e_j):
    ar_i, ai_i, br_i, bi_i = e_i
    ar_j, ai_j, br_j, bi_j = e_j
    return (ar_j * ar_i - ai_j * ai_i,
            ar_j * ai_i + ai_j * ar_i,
            ar_j * br_i - ai_j * bi_i + br_j,
            ar_j * bi_i + ai_j * br_i + bi_j)


def s5_mixer(u, lam_re, lam_im, log_step, b_re, b_im, cm_re, cm_im, d_skip, glu_w, glu_b, out_w):
    Bsz, S, _ = u.shape
    uf = u.astype(jnp.float32).reshape(Bsz, S, S5_GROUPS, S5_GROUP_CH)
    y = uf * d_skip.astype(jnp.float32).reshape(S5_GROUPS, S5_GROUP_CH)
    for di in range(2):
        lr = lam_re[di].astype(jnp.float32)
        li = lam_im[di].astype(jnp.float32)
        delta = jnp.exp(log_step[di].astype(jnp.float32))[:, None]
        mag = jnp.exp(lr * delta)
        abar_re = mag * jnp.cos(li * delta)
        abar_im = mag * jnp.sin(li * delta)
        den = lr * lr + li * li
        num_re = abar_re - 1.0
        f_re = (num_re * lr + abar_im * li) / den
        f_im = (abar_im * lr - num_re * li) / den
        br = b_re[di].astype(jnp.float32)
        bi = b_im[di].astype(jnp.float32)
        bbar_re = f_re[..., None] * br - f_im[..., None] * bi
        bbar_im = f_re[..., None] * bi + f_im[..., None] * br
        bu_re = jnp.einsum('bsgc,gpc->bsgp', uf, bbar_re)
        bu_im = jnp.einsum('bsgc,gpc->bsgp', uf, bbar_im)
        a_re = jnp.broadcast_to(abar_re, bu_re.shape)
        a_im = jnp.broadcast_to(abar_im, bu_im.shape)
        _, _, xr, xi = lax.associative_scan(complex_combine, (a_re, a_im, bu_re, bu_im),
                                            reverse=(di == 1), axis=1)
        y = y + (jnp.einsum('bsgp,gcp->bsgc', xr, cm_re[di].astype(jnp.float32))
                 - jnp.einsum('bsgp,gcp->bsgc', xi, cm_im[di].astype(jnp.float32)))
    y = jax.nn.gelu(y.reshape(Bsz, S, W_S5))
    y = y * jax.nn.sigmoid(y @ glu_w.astype(jnp.float32) + glu_b.astype(jnp.float32))
    return rms_norm(y.astype(u.dtype), out_w)


def expert_ffn(xb, w1, b1, w2, b2):
    z = xb @ w1 + b1
    x_glu = jnp.minimum(z[..., ::2], SWIGLU_LIMIT)
    x_lin = jnp.clip(z[..., 1::2], -SWIGLU_LIMIT, SWIGLU_LIMIT)
    act = x_glu * jax.nn.sigmoid(SWIGLU_ALPHA * x_glu) * (x_lin + 1.0)
    return act @ w2 + b2


def moe(h, router_w, router_b, mlp1_w, mlp1_b, mlp2_w, mlp2_b):
    B, S, D = h.shape
    T = B * S
    ht = h.reshape(T, D)
    logits = (ht @ router_w + router_b).astype(jnp.float32)
    top_vals, top_idx = lax.top_k(logits, TOP_K)
    gates = jax.nn.softmax(top_vals, axis=-1)
    n_assign = T * TOP_K
    flat_e = top_idx.reshape(-1).astype(jnp.int32)
    flat_tok = jnp.arange(n_assign, dtype=jnp.int32) // TOP_K
    flat_g = gates.reshape(-1)
    order = jnp.argsort(flat_e, stable=True)
    sorted_e = flat_e[order]
    sorted_tok = flat_tok[order]
    sorted_g = flat_g[order]
    counts = jnp.bincount(flat_e, length=N_EXPERTS).astype(jnp.int32)
    padded = ((counts + MOE_BLOCK - 1) // MOE_BLOCK) * MOE_BLOCK
    pad_end = jnp.cumsum(padded)
    pad_start = pad_end - padded
    start = jnp.cumsum(counts) - counts
    dest = pad_start[sorted_e] + jnp.arange(n_assign, dtype=jnp.int32) - start[sorted_e]
    n_rows = n_assign + N_EXPERTS * MOE_BLOCK
    n_blocks = n_rows // MOE_BLOCK
    xs = jnp.zeros((n_rows, D), h.dtype).at[dest].set(ht[sorted_tok])
    block_e = jnp.minimum(
        jnp.searchsorted(pad_end, jnp.arange(n_blocks, dtype=jnp.int32) * MOE_BLOCK, side='right'),
        N_EXPERTS - 1).astype(jnp.int32)

    def run(args):
        xb, e = args
        return expert_ffn(xb, mlp1_w[e], mlp1_b[e], mlp2_w[e], mlp2_b[e])

    ys = lax.map(run, (xs.reshape(n_blocks, MOE_BLOCK, D), block_e)).reshape(n_rows, D)
    y = ys[dest] * sorted_g[:, None].astype(ys.dtype)
    out = jnp.zeros((T, D), h.dtype).at[sorted_tok].add(y.astype(h.dtype))
    return out.reshape(B, S, D)


def setup_inputs(seed: int = 0) -> dict:
    key = jax.random.key(seed)
    ks = jax.random.split(key, 40)
    L = DEPTH
    f32 = jnp.float32

    def nrm(k, shape, s):
        return jax.random.normal(k, shape, f32) * s

    n_idx = jnp.arange(S5_STATE, dtype=f32)
    return {
        "x": nrm(ks[0], (BATCH, SEQ, D_MODEL), 1.0),
        "c": nrm(ks[1], (BATCH, D_MODEL), 1.0),
        "positions": (jnp.arange(SEQ, dtype=jnp.int32)[None, :]
                      + jax.random.randint(ks[2], (BATCH, 1), 0, POS_OFFSET_MAX, dtype=jnp.int32)),
        "ada_w": nrm(ks[3], (L, D_MODEL, 6 * D_MODEL), D_MODEL ** -0.5),
        "ada_b": nrm(ks[4], (L, 6 * D_MODEL), 0.02),
        "norm1_w": 1.0 + nrm(ks[5], (L, D_MODEL), 0.02),
        "w_in": nrm(ks[6], (L, D_MODEL, D_IN_PROJ), D_MODEL ** -0.5),
        "q_norm_w": 1.0 + nrm(ks[7], (L, ATTN_QK_DIM), 0.02),
        "k_norm_w": 1.0 + nrm(ks[8], (L, ATTN_QK_DIM), 0.02),
        "lambda_q1": nrm(ks[9], (L, ATTN_QK_DIM), 0.1),
        "lambda_k1": nrm(ks[10], (L, ATTN_QK_DIM), 0.1),
        "lambda_q2": nrm(ks[11], (L, ATTN_QK_DIM), 0.1),
        "lambda_k2": nrm(ks[12], (L, ATTN_QK_DIM), 0.1),
        "subln_w": 1.0 + nrm(ks[13], (L, ATTN_V_DIM), 0.02),
        "s5_lambda_re": -0.5 + nrm(ks[14], (L, 2, S5_GROUPS, S5_STATE), 0.01),
        "s5_lambda_im": math.pi * n_idx + nrm(ks[15], (L, 2, S5_GROUPS, S5_STATE), 0.01),
        "s5_log_step": jax.random.uniform(ks[16], (L, 2, S5_GROUPS), f32,
                                          math.log(S5_MIN_STEP), math.log(S5_MAX_STEP)),
        "s5_b_re": nrm(ks[17], (L, 2, S5_GROUPS, S5_STATE, S5_GROUP_CH), (2 * S5_GROUP_CH) ** -0.5),
        "s5_b_im": nrm(ks[18], (L, 2, S5_GROUPS, S5_STATE, S5_GROUP_CH), (2 * S5_GROUP_CH) ** -0.5),
        "s5_cmat_re": nrm(ks[19], (L, 2, S5_GROUPS, S5_GROUP_CH, S5_STATE), (2 * S5_STATE) ** -0.5),
        "s5_cmat_im": nrm(ks[20], (L, 2, S5_GROUPS, S5_GROUP_CH, S5_STATE), (2 * S5_STATE) ** -0.5),
        "s5_d": nrm(ks[21], (L, W_S5), 1.0),
        "s5_glu_w": nrm(ks[22], (L, W_S5, W_S5), W_S5 ** -0.5),
        "s5_glu_b": nrm(ks[23], (L, W_S5), 0.02),
        "s5_out_norm_w": 1.0 + nrm(ks[24], (L, W_S5), 0.02),
        "w_out": nrm(ks[25], (L, D_MIX, D_MODEL), D_MIX ** -0.5),
        "norm2_w": 1.0 + nrm(ks[26], (L, D_MODEL), 0.02),
        "router_w": nrm(ks[27], (L, D_MODEL, N_EXPERTS), D_MODEL ** -0.5),
        "router_b": nrm(ks[28], (L, N_EXPERTS), 0.01),
        "mlp1_w": nrm(ks[29], (L, N_EXPERTS, D_MODEL, 2 * D_FF), D_MODEL ** -0.5),
        "mlp1_b": nrm(ks[30], (L, N_EXPERTS, 2 * D_FF), 0.02),
        "mlp2_w": nrm(ks[31], (L, N_EXPERTS, D_FF, D_MODEL), D_FF ** -0.5),
        "mlp2_b": nrm(ks[32], (L, N_EXPERTS, D_MODEL), 0.02),
    }


def reference(x, c, positions, ada_w, ada_b, norm1_w, w_in, q_norm_w, k_norm_w,
              lambda_q1, lambda_k1, lambda_q2, lambda_k2, subln_w,
              s5_lambda_re, s5_lambda_im, s5_log_step, s5_b_re, s5_b_im, s5_cmat_re, s5_cmat_im,
              s5_d, s5_glu_w, s5_glu_b, s5_out_norm_w, w_out, norm2_w,
              router_w, router_b, mlp1_w, mlp1_b, mlp2_w, mlp2_b):
    cos, sin = rope_tables(positions)
    c_act = jax.nn.silu(c)
    for l in range(DEPTH):
        mod = c_act @ ada_w[l] + ada_b[l]
        sh1, sc1, g1, sh2, sc2, g2 = jnp.split(mod[:, None, :], 6, axis=-1)
        h = rms_norm(x, norm1_w[l]) * (1.0 + sc1) + sh1
        proj = h @ w_in[l]
        q, k, v, u = jnp.split(proj, [W_ATTN_QK, 2 * W_ATTN_QK, 2 * W_ATTN_QK + W_ATTN], axis=-1)
        lambda_init = 0.8 - 0.6 * math.exp(-0.3 * l)
        lam = (jnp.exp(jnp.sum(lambda_q1[l].astype(jnp.float32) * lambda_k1[l].astype(jnp.float32)))
               - jnp.exp(jnp.sum(lambda_q2[l].astype(jnp.float32) * lambda_k2[l].astype(jnp.float32)))
               + lambda_init)
        a_out = diff_attention(q, k, v, cos, sin, q_norm_w[l], k_norm_w[l], lam, subln_w[l], lambda_init)
        s_out = s5_mixer(u, s5_lambda_re[l], s5_lambda_im[l], s5_log_step[l], s5_b_re[l], s5_b_im[l],
                         s5_cmat_re[l], s5_cmat_im[l], s5_d[l], s5_glu_w[l], s5_glu_b[l],
                         s5_out_norm_w[l])
        mix = jnp.concatenate([a_out, s_out], axis=-1) @ w_out[l]
        x = x + g1 * mix
        h2 = rms_norm(x, norm2_w[l]) * (1.0 + sc2) + sh2
        x = x + g2 * moe(h2, router_w[l], router_b[l], mlp1_w[l], mlp1_b[l], mlp2_w[l], mlp2_b[l])
    return x
```

```cpp
#include <hip/hip_runtime.h>
#include <cstdio>
#include <cstdint>

__device__ __forceinline__ int olane() { int t; asm volatile("v_mbcnt_lo_u32_b32 %0, -1, 0\n\tv_mbcnt_hi_u32_b32 %0, -1, %0" : "=v"(t)); return t; }
#define otid() ((wv_ << 6) | olane())
template <int M> __device__ __forceinline__ float shx(float v) { return __builtin_bit_cast(float, __builtin_amdgcn_ds_swizzle(__builtin_bit_cast(int, v), (M << 10) | 0x1f)); }
__device__ __forceinline__ float sum32(float v) { return v + __builtin_bit_cast(float, __builtin_amdgcn_ds_bpermute((olane() ^ 32) << 2, __builtin_bit_cast(int, v))); }
namespace pg8 {
#define PG8_LAS __attribute__((address_space(3)))
typedef unsigned short bf16_t;
typedef short bf16x8 __attribute__((ext_vector_type(8)));
typedef float f32x4 __attribute__((ext_vector_type(4)));
typedef unsigned u32x4 __attribute__((ext_vector_type(4)));
typedef unsigned u32x2 __attribute__((ext_vector_type(2)));
constexpr int BM = 256, BK = 64, HALF = 128, HTB = HALF * BK * 2  , STAGE_BYTES = 8 * HTB, NXCD = 8, WGM = 8;

__host__ __device__ __forceinline__ int lds_byte(int r, int c) { const int st = (r >> 4) * 2 + (c >> 5), rr = r & 15, cc = c & 31, ob = rr * 64 + cc * 2; return st * 1024 + (ob ^ (((ob >> 9) & 1) << 5)); }
__host__ __device__ __forceinline__ void stage_rc(int b, int& R, int& C) { const int st = b / 1024, sb = b % 1024, swz = sb ^ (((sb >> 9) & 1) << 5); R = (st >> 1) * 16 + swz / 64; C = (st & 1) * 32 + (swz % 64) / 2; }
__host__ __device__ __forceinline__ int perm32(int rho) { const int n = rho >> 4, i = rho & 15; return 8 * (i >> 2) + 4 * n + (i & 3); }

struct Unit { int pm, pn, e, slot; };

struct StaticOrder {
    int nM, nN, nwg, G, c;
    __host__ __device__ void init(int nM_, int nN_, int G_, int c_) { nM = nM_; nN = nN_; nwg = nM * nN; G = G_; c = c_; }
    __host__ __device__ bool next(int i, Unit& u) const {
        const long L = (long)i * G + c; if (L >= nwg) return false;
        int wgid = (int)L; { const int q = nwg / NXCD, r = nwg % NXCD, xcd = wgid % NXCD, off = wgid / NXCD; wgid = (xcd < r ? xcd * (q + 1) : r * (q + 1) + (xcd - r) * q) + off; }
        const int nig = WGM * nN, gid = wgid / nig, fm = gid * WGM, gsz = (nM - fm) < WGM ? (nM - fm) : WGM;
        u.pm = fm + ((wgid % nig) % gsz); u.pn = (wgid % nig) / gsz; u.e = 0; u.slot = i & 1; return true;
    }
};
struct DenseSched {
    StaticOrder o; const char* A; const char* Bt;
    const float* sideP; PG8_LAS unsigned char* side; int wv;
    __device__ __forceinline__ bool next(int i, Unit& u) const { return o.next(i, u); }
    __device__ __forceinline__ const char* a_base(const Unit& u, size_t tstep) const { return A + (size_t)u.pm * tstep; }
    __device__ __forceinline__ const char* b_base(const Unit& u, size_t tstep) const { return Bt + (size_t)u.pn * tstep; }
    __device__ __forceinline__ const char* a_root() const { return A; }
    __device__ __forceinline__ const char* b_root() const { return Bt; }
    __device__ __forceinline__ void a_ready(const Unit& u) const {
        if (sideP) __builtin_amdgcn_global_load_lds((const unsigned*)(sideP + (size_t)u.pm * 2048 + wv * 256 + olane() * 4), (PG8_LAS unsigned*)(side + wv * 1024), 16, 0, 0); }
    __device__ __forceinline__ void done(const Unit&) const {}
};
struct GroupSched {
    StaticOrder o; const char* A; const char* W; size_t estride; const PG8_LAS int* block_e;
    const float* bias; int bias_ld; const float* rowgate; PG8_LAS unsigned char* side; int wv;
    __device__ __forceinline__ bool next(int i, Unit& u) const { if (!o.next(i, u)) return false; u.e = __builtin_amdgcn_readfirstlane(block_e[u.pm]); return true; }
    __device__ __forceinline__ const char* a_base(const Unit& u, size_t tstep) const { return A + (size_t)u.pm * tstep; }
    __device__ __forceinline__ const char* b_base(const Unit& u, size_t tstep) const { return W + (size_t)u.e * estride + (size_t)u.pn * tstep; }
    __device__ __forceinline__ const char* a_root() const { return A; }
    __device__ __forceinline__ const char* b_root() const { return W; }
    __device__ __forceinline__ void a_ready(const Unit& u) const {
        const int ln = olane();
        if (wv == 0) __builtin_amdgcn_global_load_lds((const unsigned*)(bias + (size_t)u.e * bias_ld + u.pn * 256 + ln * 4), (PG8_LAS unsigned*)(side + u.slot * 2048), 16, 0, 0);
        if (wv == 1 && rowgate) __builtin_amdgcn_global_load_lds((const unsigned*)(rowgate + (size_t)u.pm * 256 + ln * 4), (PG8_LAS unsigned*)(side + u.slot * 2048 + 1024), 16, 0, 0);
    }
    __device__ __forceinline__ void done(const Unit&) const {}
};

__device__ __forceinline__ unsigned cvt_pk_bf16(float lo, float hi) { unsigned r; asm volatile("v_cvt_pk_bf16_f32 %0, %1, %2" : "=v"(r) : "v"(lo), "v"(hi)); return r; }

struct EpiBf16 {
    static constexpr bool PERM = true, AFTER_DRAIN = false, HAS_MID = false;
    bf16_t* O; int ldc; const float* bias;
    __device__ __forceinline__ void operator()(const f32x4 (&acc)[2][2][4][2], const Unit& u, int wr, int wc, int fr, int fq) const {
        const int row0 = u.pm * BM + wr * 64 + fr; const int col0 = u.pn * BM + wc * 32 + 8 * fq;
        f32x4 bv[2][2];
#pragma unroll
        for (int bj = 0; bj < 2; ++bj)
#pragma unroll
            for (int n = 0; n < 2; ++n) bv[bj][n] = bias ? *(const f32x4*)(bias + col0 + bj * HALF + 4 * n) : (f32x4){0.f, 0.f, 0.f, 0.f};
#pragma unroll
        for (int ai = 0; ai < 2; ++ai)
#pragma unroll
            for (int m = 0; m < 4; ++m) { bf16_t* rowp = O + (size_t)(row0 + ai * HALF + m * 16) * ldc + col0;
#pragma unroll
                for (int bj = 0; bj < 2; ++bj) { const f32x4 v0 = acc[ai][bj][m][0] + bv[bj][0], v1 = acc[ai][bj][m][1] + bv[bj][1];
                    u32x4 w; w.x = cvt_pk_bf16(v0[0], v0[1]); w.y = cvt_pk_bf16(v0[2], v0[3]); w.z = cvt_pk_bf16(v1[0], v1[1]); w.w = cvt_pk_bf16(v1[2], v1[3]);
                    *(u32x4*)(rowp + bj * HALF) = w; } }
    }
};

__device__ __forceinline__ unsigned pk4_fp8(float a, float b, float c, float d) { int r = __builtin_amdgcn_cvt_pk_fp8_f32(a, b, 0, false); r = __builtin_amdgcn_cvt_pk_fp8_f32(c, d, r, true); return (unsigned)r; }
struct EpiProj {
    static constexpr bool PERM = true, AFTER_DRAIN = false, HAS_MID = false;
    bf16_t *QG, *KG, *VTG, *UG; const float *qnw, *knw, *CS; float qscale, ascale;
    __device__ __forceinline__ void operator()(const f32x4 (&acc)[2][2][4][2], const Unit& u, int wr, int wc, int fr, int fq) const {
        constexpr int SEQ_ = 8192;
        const int row0 = u.pm * BM + wr * 64 + fr;
        if (u.pn < 4) {
            const bool isk = u.pn >= 2; const float* nw = (isk ? knw : qnw) + 8 * fq; bf16_t* dstb = isk ? KG : QG; const float sc = isk ? 1.0f : qscale;
            const f32x4 w0 = *(const f32x4*)nw, w1 = *(const f32x4*)(nw + 4);
#pragma unroll
            for (int ai = 0; ai < 2; ++ai)
#pragma unroll
                for (int m = 0; m < 4; ++m) { const int row = row0 + ai * HALF + m * 16, b = row / SEQ_, s = row % SEQ_;
                    const f32x4 c4 = *(const f32x4*)(CS + (size_t)row * 8), s4 = *(const f32x4*)(CS + (size_t)row * 8 + 4);
#pragma unroll
                    for (int bj = 0; bj < 2; ++bj) { const int hm = (u.pn & 1) * 8 + bj * 4 + wc;
                        const f32x4 v0 = acc[ai][bj][m][0] * ascale, v1 = acc[ai][bj][m][1] * ascale;
                        float ss = (v0[0] * v0[0] + v0[1] * v0[1]) + (v0[2] * v0[2] + v0[3] * v0[3]) + (v1[0] * v1[0] + v1[1] * v1[1]) + (v1[2] * v1[2] + v1[3] * v1[3]);
                        ss += shx<16>(ss); ss = sum32(ss);
                        const float rstd = rsqrtf(ss * (1.0f / 32.0f) + 1e-6f);
                        f32x4 y0 = v0 * rstd * w0, y1 = v1 * rstd * w1;
                        const f32x4 r0 = y0 * c4 - y1 * s4, r1 = y1 * c4 + y0 * s4;
                        if (fq == 0) { y0 = r0; y1 = r1; }
                        y0 = y0 * sc; y1 = y1 * sc;
                        u32x4 w; w.x = cvt_pk_bf16(y0[0], y0[1]); w.y = cvt_pk_bf16(y0[2], y0[3]); w.z = cvt_pk_bf16(y1[0], y1[1]); w.w = cvt_pk_bf16(y1[2], y1[3]);
                        *(u32x4*)(dstb + ((size_t)((b * 8 + (hm >> 1)) * SEQ_ + s)) * 64 + (hm & 1) * 32 + 8 * fq) = w; } }
        } else if (u.pn < 6) {
#pragma unroll
            for (int ai = 0; ai < 2; ++ai)
#pragma unroll
                for (int m = 0; m < 4; ++m) { const int row = row0 + ai * HALF + m * 16, b = row / SEQ_, s = row % SEQ_;
#pragma unroll
                    for (int bj = 0; bj < 2; ++bj) { const int h = 4 * (u.pn - 4) + 2 * bj + (wc >> 1), dv0 = (wc & 1) * 32 + 8 * fq;
                        unsigned char* pv = (unsigned char*)VTG + ((size_t)((b * 8 + h) * 64 + dv0)) * SEQ_ + s;
#pragma unroll
                        for (int n = 0; n < 2; ++n) { const f32x4 v = acc[ai][bj][m][n] * ascale; const unsigned a = pk4_fp8(v[0], v[1], v[2], v[3]);
                            pv[(size_t)(4 * n + 0) * SEQ_] = (unsigned char)(a & 0xffu); pv[(size_t)(4 * n + 1) * SEQ_] = (unsigned char)((a >> 8) & 0xffu);
                            pv[(size_t)(4 * n + 2) * SEQ_] = (unsigned char)((a >> 16) & 0xffu); pv[(size_t)(4 * n + 3) * SEQ_] = (unsigned char)(a >> 24); } } }
        } else {
#pragma unroll
            for (int ai = 0; ai < 2; ++ai)
#pragma unroll
                for (int m = 0; m < 4; ++m) { const int row = row0 + ai * HALF + m * 16, b = row / SEQ_, s = row % SEQ_;
#pragma unroll
                    for (int bj = 0; bj < 2; ++bj) { const int g = 16 * (u.pn - 6) + 8 * bj + 2 * wc + (fq >> 1), ch0 = (fq & 1) * 8;
                        const f32x4 v0 = acc[ai][bj][m][0] * ascale, v1 = acc[ai][bj][m][1] * ascale;
                        u32x4 w; w.x = cvt_pk_bf16(v0[0], v0[1]); w.y = cvt_pk_bf16(v0[2], v0[3]); w.z = cvt_pk_bf16(v1[0], v1[1]); w.w = cvt_pk_bf16(v1[2], v1[3]);
                        *(u32x4*)(UG + ((size_t)((b * 32 + g) * SEQ_ + s)) * 16 + ch0) = w; } }
        }
    }
};

struct EpiGlu {
    static constexpr bool PERM = true, AFTER_DRAIN = false, HAS_MID = false;
    const bf16_t* YP; const float* bias; bf16_t* MIX; float* PART;
    __device__ __forceinline__ void operator()(const f32x4 (&acc)[2][2][4][2], const Unit& u, int wr, int wc, int fr, int fq) const {
        const int row0 = u.pm * BM + wr * 64 + fr; const int col0 = u.pn * BM + wc * 32 + 8 * fq;
        f32x4 bv[2][2];
#pragma unroll
        for (int bj = 0; bj < 2; ++bj)
#pragma unroll
            for (int n = 0; n < 2; ++n) bv[bj][n] = *(const f32x4*)(bias + col0 + bj * HALF + 4 * n);
#pragma unroll
        for (int ai = 0; ai < 2; ++ai)
#pragma unroll
            for (int m = 0; m < 4; ++m) { const int row = row0 + ai * HALF + m * 16; float ss = 0.f;
#pragma unroll
                for (int bj = 0; bj < 2; ++bj) { const u32x4 yw = *(const u32x4*)(YP + (size_t)row * 512 + col0 + bj * HALF);
                    const f32x4 z0 = acc[ai][bj][m][0] + bv[bj][0], z1 = acc[ai][bj][m][1] + bv[bj][1];
                    float s[8]; const unsigned yy[4] = {yw.x, yw.y, yw.z, yw.w};
#pragma unroll
                    for (int k = 0; k < 4; ++k) { const float zl = k < 2 ? z0[2 * k] : z1[2 * k - 4], zh = k < 2 ? z0[2 * k + 1] : z1[2 * k - 3];
                        s[2 * k] = __builtin_bit_cast(float, yy[k] << 16) * __builtin_amdgcn_rcpf(1.0f + __expf(-zl)); s[2 * k + 1] = __builtin_bit_cast(float, yy[k] & 0xffff0000u) * __builtin_amdgcn_rcpf(1.0f + __expf(-zh)); }
#pragma unroll
                    for (int k = 0; k < 8; ++k) ss += s[k] * s[k];
                    u32x4 w; w.x = cvt_pk_bf16(s[0], s[1]); w.y = cvt_pk_bf16(s[2], s[3]); w.z = cvt_pk_bf16(s[4], s[5]); w.w = cvt_pk_bf16(s[6], s[7]);
                    *(u32x4*)(MIX + (size_t)row * 1024 + col0 + bj * HALF) = w; }
                ss += shx<16>(ss); ss = sum32(ss);
                if (fq == 0) PART[(size_t)row * 8 + u.pn * 4 + wc] = ss; }
    }
};

struct EpiXmid {
    static constexpr bool PERM = true, AFTER_DRAIN = false, HAS_MID = true;
    const float* X; const float* G1; bf16_t* XM; float* PART; PG8_LAS unsigned char* side;
    __device__ __forceinline__ void mid(f32x4 (&acc)[2][2][4][2], const Unit& u, int wr, int wc, int fr, int fq) const {
#pragma unroll
        for (int ai = 0; ai < 2; ++ai)
#pragma unroll
            for (int m = 0; m < 4; ++m) { const PG8_LAS f32x4* pp = (const PG8_LAS f32x4*)(side + (ai * HALF + wr * 64 + m * 16 + fr) * 32); const f32x4 a = pp[0], b = pp[1];
                const float rs = rsqrtf((((a[0] + a[1]) + (a[2] + a[3])) + ((b[0] + b[1]) + (b[2] + b[3]))) * (1.0f / 512.0f) + 1e-6f);
#pragma unroll
                for (int bj = 0; bj < 2; ++bj)
#pragma unroll
                    for (int n = 0; n < 2; ++n) acc[ai][bj][m][n] = acc[ai][bj][m][n] * rs; }
    }
    __device__ __forceinline__ void operator()(const f32x4 (&acc)[2][2][4][2], const Unit& u, int wr, int wc, int fr, int fq) const {
        const int row0 = u.pm * BM + wr * 64 + fr; const int col0 = u.pn * BM + wc * 32 + 8 * fq; const int b = (u.pm * BM) / 8192;
        f32x4 gv[2][2];
#pragma unroll
        for (int bj = 0; bj < 2; ++bj)
#pragma unroll
            for (int n = 0; n < 2; ++n) gv[bj][n] = *(const f32x4*)(G1 + (size_t)b * 6144 + col0 + bj * HALF + 4 * n);
#pragma unroll
        for (int ai = 0; ai < 2; ++ai)
#pragma unroll
            for (int m = 0; m < 4; ++m) { const int row = row0 + ai * HALF + m * 16; const float* xr = X + (size_t)row * 1024 + col0; bf16_t* orow = XM + (size_t)row * 1024 + col0; float ss = 0.f;
#pragma unroll
                for (int bj = 0; bj < 2; ++bj) { const f32x4 x0 = *(const f32x4*)(xr + bj * HALF), x1 = *(const f32x4*)(xr + bj * HALF + 4);
                    const f32x4 v0 = x0 + gv[bj][0] * acc[ai][bj][m][0], v1 = x1 + gv[bj][1] * acc[ai][bj][m][1];
                    ss += (v0[0] * v0[0] + v0[1] * v0[1]) + (v0[2] * v0[2] + v0[3] * v0[3]) + (v1[0] * v1[0] + v1[1] * v1[1]) + (v1[2] * v1[2] + v1[3] * v1[3]);
                    u32x4 w; w.x = cvt_pk_bf16(v0[0], v0[1]); w.y = cvt_pk_bf16(v0[2], v0[3]); w.z = cvt_pk_bf16(v1[0], v1[1]); w.w = cvt_pk_bf16(v1[2], v1[3]);
                    *(u32x4*)(orow + bj * HALF) = w; }
                ss += shx<16>(ss); ss = sum32(ss);
                if (fq == 0) PART[(size_t)row * 16 + u.pn * 4 + wc] = ss; }
    }
};

__device__ __forceinline__ float swiglu1(float g, float l) {
    const float xg = fminf(g, 7.0f), xl = __builtin_amdgcn_fmed3f(l, -7.0f, 7.0f);
    return xg * __builtin_amdgcn_rcpf(1.0f + __builtin_amdgcn_exp2f(-1.702f * 1.4426950408889634f * xg)) * (xl + 1.0f);
}
struct EpiSwiglu8 {
    static constexpr bool PERM = true, AFTER_DRAIN = false, HAS_MID = false;
    unsigned char* O; PG8_LAS unsigned char* side; float ascale;
    __device__ __forceinline__ void operator()(const f32x4 (&acc)[2][2][4][2], const Unit& u, int wr, int wc, int fr, int fq) const {
        const int row0 = u.pm * BM + wr * 64 + fr; const int col0 = u.pn * BM + wc * 32 + 8 * fq;
        const PG8_LAS float* bias = (const PG8_LAS float*)(side + u.slot * 2048) + wc * 32 + 8 * fq;
        f32x4 bv[2][2];
#pragma unroll
        for (int bj = 0; bj < 2; ++bj)
#pragma unroll
            for (int n = 0; n < 2; ++n) bv[bj][n] = *(const PG8_LAS f32x4*)(bias + bj * HALF + 4 * n);
#pragma unroll
        for (int ai = 0; ai < 2; ++ai)
#pragma unroll
            for (int m = 0; m < 4; ++m) { unsigned char* rowp = O + (size_t)(row0 + ai * HALF + m * 16) * 1024 + (col0 >> 1);
#pragma unroll
                for (int bj = 0; bj < 2; ++bj) { const f32x4 v0 = acc[ai][bj][m][0] * ascale + bv[bj][0], v1 = acc[ai][bj][m][1] * ascale + bv[bj][1];
                    *(unsigned*)(rowp + bj * (HALF / 2)) = pk4_fp8(swiglu1(v0[0], v0[1]), swiglu1(v0[2], v0[3]), swiglu1(v1[0], v1[1]), swiglu1(v1[2], v1[3])); } }
    }
};
struct EpiRowScale {
    static constexpr bool PERM = true, AFTER_DRAIN = false, HAS_MID = false;
    unsigned char* O; PG8_LAS unsigned char* side; float ascale, oscale;
    __device__ __forceinline__ void operator()(const f32x4 (&acc)[2][2][4][2], const Unit& u, int wr, int wc, int fr, int fq) const {
        const int row0 = u.pm * BM + wr * 64 + fr; const int col0 = u.pn * BM + wc * 32 + 8 * fq;
        const PG8_LAS float* bias = (const PG8_LAS float*)(side + u.slot * 2048) + wc * 32 + 8 * fq; const PG8_LAS float* gates = (const PG8_LAS float*)(side + u.slot * 2048 + 1024) + wr * 64 + fr;
        f32x4 bv[2][2];
#pragma unroll
        for (int bj = 0; bj < 2; ++bj)
#pragma unroll
            for (int n = 0; n < 2; ++n) bv[bj][n] = *(const PG8_LAS f32x4*)(bias + bj * HALF + 4 * n);
#pragma unroll
        for (int ai = 0; ai < 2; ++ai)
#pragma unroll
            for (int m = 0; m < 4; ++m) { const int row = row0 + ai * HALF + m * 16; const float gt = gates[ai * HALF + m * 16] * oscale; unsigned char* rowp = O + (size_t)row * 1024 + col0;
#pragma unroll
                for (int bj = 0; bj < 2; ++bj) { const f32x4 v0 = (acc[ai][bj][m][0] * ascale + bv[bj][0]) * gt, v1 = (acc[ai][bj][m][1] * ascale + bv[bj][1]) * gt;
                    u32x2 w; w.x = pk4_fp8(v0[0], v0[1], v0[2], v0[3]); w.y = pk4_fp8(v1[0], v1[1], v1[2], v1[3]);
                    *(u32x2*)(rowp + bj * HALF) = w; } }
    }
};

#ifndef PG8_SCALE1
#define PG8_SCALE1 0
#endif
typedef int i32x4g __attribute__((ext_vector_type(4)));
typedef int i32x8g __attribute__((ext_vector_type(8)));
__device__ __forceinline__ i32x8g pg8_cat(bf16x8 lo, bf16x8 hi) { const i32x4g a = __builtin_bit_cast(i32x4g, lo), b = __builtin_bit_cast(i32x4g, hi); return __builtin_shufflevector(a, b, 0, 1, 2, 3, 4, 5, 6, 7); }
template <class Epi, class Sched, bool ALIGN_EPI = false, bool SP2 = false, bool FP8 = false>
__device__ __forceinline__ void gemm_phase(const int wv_, PG8_LAS unsigned char* lds, const int K, const Sched& S, const Epi& E) {
    const int tid = otid(), wid = __builtin_amdgcn_readfirstlane(tid >> 6), lane = tid & 63, wr = wid >> 2, wc = wid & 3, fr = lane & 15, fq = lane >> 4;
    const int nt = K / BK;
    unsigned voffA[2], voffB[2];
#pragma unroll
    for (int i = 0; i < 2; ++i) { int R, C; stage_rc(tid * 16 + i * 8192, R, C); const int Rb = Epi::PERM ? ((R & ~31) + perm32(R & 31)) : R;
        voffA[i] = (unsigned)(R * K + C) * 2u; voffB[i] = (unsigned)(Rb * K + C) * 2u; }
    const char* rootA = S.a_root(); const char* rootB = S.b_root();
    const __amdgpu_buffer_rsrc_t rsA = __builtin_amdgcn_make_buffer_rsrc((void*)rootA, 0, 0x7fffffff, 0x00020000), rsB = __builtin_amdgcn_make_buffer_rsrc((void*)rootB, 0, 0x7fffffff, 0x00020000);
    const size_t kstep = (size_t)(BK * 2);
    const size_t hstep = (size_t)HALF * K * 2;
    const size_t tstep = 2 * hstep;
    const unsigned ldsw = (unsigned)wid * 1024u;
    const int aoff = lds_byte(wr * 64 + fr, fq * 8), boff = lds_byte(wc * 32 + fr, fq * 8);
    constexpr int KOFF = 1024;
#define PG8_SA(b, h) (((b) * 2 + (h)) * HTB)
#define PG8_SB(b, h) ((4 + (b) * 2 + (h)) * HTB)
#define PG8_STAGE(bufoff, gbase, voff) do { const bool isA_ = (+(voff) == +voffA); const unsigned so_ = (unsigned)((gbase) - (isA_ ? rootA : rootB)); \
        _Pragma("unroll") for (int _i = 0; _i < 2; ++_i) __builtin_amdgcn_raw_ptr_buffer_load_lds(isA_ ? rsA : rsB, (PG8_LAS void*)(lds + (bufoff) + ldsw + _i * 8192), 16, (voff)[_i], so_, 0, 0); } while (0)
#define PG8_LDA(dst, b, h) do { _Pragma("unroll") for (int m = 0; m < 4; ++m) _Pragma("unroll") for (int k = 0; k < 2; ++k) dst[m][k] = *(const PG8_LAS bf16x8*)(lds + PG8_SA(b, h) + aoff + m * 2048 + k * KOFF); } while (0)
#define PG8_LDB(dst, b, h) do { _Pragma("unroll") for (int n = 0; n < 2; ++n) _Pragma("unroll") for (int k = 0; k < 2; ++k) dst[n][k] = *(const PG8_LAS bf16x8*)(lds + PG8_SB(b, h) + boff + n * 2048 + k * KOFF); } while (0)
#define PG8_MMA(ai, bj, At, Bt) do { __builtin_amdgcn_s_setprio(1); \
        if constexpr (FP8) { _Pragma("unroll") for (int m = 0; m < 4; ++m) _Pragma("unroll") for (int n = 0; n < 2; ++n) \
            acc[ai][bj][m][n] = __builtin_amdgcn_mfma_scale_f32_16x16x128_f8f6f4(pg8_cat(Bt[n][0], Bt[n][1]), pg8_cat(At[m][0], At[m][1]), acc[ai][bj][m][n], 0, 0, 0, PG8_SCALE1, 0, PG8_SCALE1); } \
        else { _Pragma("unroll") for (int m = 0; m < 4; ++m) _Pragma("unroll") for (int n = 0; n < 2; ++n) _Pragma("unroll") for (int k = 0; k < 2; ++k) \
            acc[ai][bj][m][n] = __builtin_amdgcn_mfma_f32_16x16x32_bf16(Bt[n][k], At[m][k], acc[ai][bj][m][n], 0, 0, 0); } __builtin_amdgcn_s_setprio(0); } while (0)
#define PG8_WAIT_V(n) asm volatile("s_waitcnt vmcnt(" #n ")" ::: "memory")
#define PG8_WAIT_L(n) asm volatile("s_waitcnt lgkmcnt(" #n ")" ::: "memory")
#define PG8_BAR __builtin_amdgcn_s_barrier()
#define PG8_SCHED __builtin_amdgcn_sched_barrier(0)
    Unit cur, nxt; int ui = 0;
    if (!S.next(0, cur)) return;
    f32x4 acc[2][2][4][2];
#pragma unroll
    for (int a = 0; a < 2; ++a)
#pragma unroll
        for (int b = 0; b < 2; ++b)
#pragma unroll
            for (int m = 0; m < 4; ++m)
#pragma unroll
                for (int n = 0; n < 2; ++n) acc[a][b][m][n] = (f32x4){0.f, 0.f, 0.f, 0.f};
    bf16x8 At[4][2], B0[2][2], B1[2][2];
    const char* cA = S.a_base(cur, tstep); const char* cB = S.b_base(cur, tstep);
    S.a_ready(cur);
    if constexpr (SP2) {
        PG8_STAGE(PG8_SB(0, 0), cB, voffB); PG8_STAGE(PG8_SB(0, 1), cB + hstep, voffB); PG8_STAGE(PG8_SA(0, 0), cA, voffA); PG8_STAGE(PG8_SA(0, 1), cA + hstep, voffA);
        if (wr == 1) PG8_BAR;
        PG8_WAIT_V(2); PG8_BAR;
        PG8_STAGE(PG8_SB(1, 0), cB + kstep, voffB); PG8_STAGE(PG8_SA(1, 0), cA + kstep, voffA); PG8_STAGE(PG8_SB(1, 1), cB + hstep + kstep, voffB);
        PG8_WAIT_V(6); PG8_BAR;
    } else {
        PG8_STAGE(PG8_SB(0, 0), cB, voffB); PG8_STAGE(PG8_SA(0, 0), cA, voffA); PG8_STAGE(PG8_SB(0, 1), cB + hstep, voffB); PG8_STAGE(PG8_SA(0, 1), cA + hstep, voffA);
        if (wr == 1) PG8_BAR;
        PG8_WAIT_V(4); PG8_BAR;
        PG8_STAGE(PG8_SB(1, 0), cB + kstep, voffB); PG8_STAGE(PG8_SA(1, 0), cA + kstep, voffA); PG8_STAGE(PG8_SB(1, 1), cB + hstep + kstep, voffB);
        PG8_WAIT_V(6); PG8_BAR;
    }
    for (;;) {
        const bool has_next = S.next(ui + 1, nxt);
        const char* nA = has_next ? S.a_base(nxt, tstep) : cA; const char* nB = has_next ? S.b_base(nxt, tstep) : cB;
#pragma unroll 1
        for (int t = 0; t < nt; t += 2) {
            const bool last = (t == nt - 2);
            const char* a1 = cA + (size_t)(t + 1) * kstep;
            const char* a2 = last ? nA : cA + (size_t)(t + 2) * kstep; const char* b2 = last ? nB : cB + (size_t)(t + 2) * kstep;
            const char* a3 = a2 + kstep; const char* b3 = b2 + kstep;
            if constexpr (Epi::HAS_MID) { if (t == nt / 2) { const int lm_ = olane(); E.mid(acc, cur, wr, wc, lm_ & 15, lm_ >> 4); } }
            if (last && has_next) S.a_ready(nxt);
            if constexpr (SP2) {
            PG8_LDB(B0, 0, 0); PG8_LDB(B1, 0, 1); PG8_SCHED; PG8_LDA(At, 0, 0); PG8_STAGE(PG8_SA(1, 1), a1 + hstep, voffA);
            PG8_WAIT_V(8); PG8_WAIT_L(0); PG8_BAR; PG8_MMA(0, 0, At, B0); PG8_MMA(0, 1, At, B1); PG8_BAR; PG8_SCHED;
            PG8_LDA(At, 0, 1); PG8_STAGE(PG8_SB(0, 0), b2, voffB); PG8_STAGE(PG8_SB(0, 1), b2 + hstep, voffB); PG8_STAGE(PG8_SA(0, 0), a2, voffA);
            PG8_WAIT_V(8); PG8_WAIT_L(0); PG8_BAR; PG8_MMA(1, 0, At, B0); PG8_MMA(1, 1, At, B1); PG8_BAR; PG8_SCHED;
            PG8_LDB(B0, 1, 0); PG8_LDB(B1, 1, 1); PG8_SCHED; PG8_LDA(At, 1, 0); PG8_STAGE(PG8_SA(0, 1), a2 + hstep, voffA);
            PG8_WAIT_V(8); PG8_WAIT_L(0); PG8_BAR; PG8_MMA(0, 0, At, B0); PG8_MMA(0, 1, At, B1); PG8_BAR; PG8_SCHED;
            PG8_LDA(At, 1, 1); PG8_STAGE(PG8_SB(1, 0), b3, voffB); PG8_STAGE(PG8_SB(1, 1), b3 + hstep, voffB); PG8_STAGE(PG8_SA(1, 0), a3, voffA);
            PG8_WAIT_V(8); PG8_WAIT_L(0); PG8_BAR; PG8_MMA(1, 0, At, B0); PG8_MMA(1, 1, At, B1); PG8_BAR; PG8_SCHED;
            } else {
            PG8_LDB(B0, 0, 0); PG8_SCHED; PG8_LDA(At, 0, 0); PG8_STAGE(PG8_SA(1, 1), a1 + hstep, voffA);
            PG8_WAIT_L(8); PG8_BAR; PG8_WAIT_L(0); PG8_MMA(0, 0, At, B0); PG8_BAR; PG8_SCHED;
            PG8_LDB(B1, 0, 1); PG8_STAGE(PG8_SB(0, 0), b2, voffB);
            PG8_BAR; PG8_WAIT_L(0); PG8_MMA(0, 1, At, B1); PG8_BAR;
            PG8_LDA(At, 0, 1); PG8_STAGE(PG8_SA(0, 0), a2, voffA);
            PG8_BAR; PG8_WAIT_L(0); PG8_MMA(1, 0, At, B0); PG8_BAR; PG8_SCHED;
            PG8_STAGE(PG8_SB(0, 1), b2 + hstep, voffB);
            PG8_WAIT_V(6); PG8_BAR; PG8_MMA(1, 1, At, B1); PG8_BAR;
            PG8_LDB(B0, 1, 0); PG8_SCHED; PG8_LDA(At, 1, 0); PG8_STAGE(PG8_SA(0, 1), a2 + hstep, voffA);
            PG8_WAIT_L(8); PG8_BAR; PG8_WAIT_L(0); PG8_MMA(0, 0, At, B0); PG8_BAR; PG8_SCHED;
            PG8_LDB(B1, 1, 1); PG8_STAGE(PG8_SB(1, 0), b3, voffB);
            PG8_BAR; PG8_WAIT_L(0); PG8_MMA(0, 1, At, B1); PG8_BAR;
            PG8_LDA(At, 1, 1); PG8_STAGE(PG8_SA(1, 0), a3, voffA);
            PG8_BAR; PG8_WAIT_L(0); PG8_MMA(1, 0, At, B0); PG8_BAR; PG8_SCHED;
            PG8_STAGE(PG8_SB(1, 1), b3 + hstep, voffB);
            PG8_WAIT_V(6); PG8_BAR; PG8_MMA(1, 1, At, B1); PG8_BAR;
            }
        }
        if constexpr (ALIGN_EPI) { if (wr == 0) PG8_BAR; }
        if constexpr (!Epi::AFTER_DRAIN) { const int le_ = olane(); E(acc, cur, wr, wc, le_ & 15, le_ >> 4); S.done(cur); }
        if (!has_next) break;
#pragma unroll
        for (int a = 0; a < 2; ++a)
#pragma unroll
            for (int b = 0; b < 2; ++b)
#pragma unroll
                for (int m = 0; m < 4; ++m)
#pragma unroll
                    for (int n = 0; n < 2; ++n) acc[a][b][m][n] = (f32x4){0.f, 0.f, 0.f, 0.f};
        cur = nxt; cA = nA; cB = nB; ++ui;
        if constexpr (ALIGN_EPI) { if (wr == 1) PG8_BAR; }
    }
    PG8_WAIT_V(0);
    if constexpr (!ALIGN_EPI) { if (wr == 0) PG8_BAR; }
    PG8_BAR;
    if constexpr (Epi::AFTER_DRAIN) { E.fused(acc, cur, wr, wc, fr, fq, lds, wid, lane); S.done(cur); }
#undef PG8_SA
#undef PG8_SB
#undef PG8_STAGE
#undef PG8_LDA
#undef PG8_LDB
#undef PG8_MMA
#undef PG8_WAIT_V
#undef PG8_WAIT_L
#undef PG8_BAR
#undef PG8_SCHED
}
}

#define GAS __attribute__((address_space(1)))
#define LAS __attribute__((address_space(3)))
typedef unsigned short bf16;
typedef unsigned v4u __attribute__((ext_vector_type(4)));
typedef unsigned v2u __attribute__((ext_vector_type(2)));
typedef float f32x4 __attribute__((ext_vector_type(4)));
#define LDS_WAIT() asm volatile("s_waitcnt lgkmcnt(0)" ::: "memory")
#define VM_WAIT() asm volatile("s_waitcnt vmcnt(0)" ::: "memory")
__device__ __forceinline__ unsigned f2bf(float f) { unsigned u = __builtin_bit_cast(unsigned, f); return (u + 0x7fffu + ((u >> 16) & 1u)) >> 16; }
typedef float f32x2q __attribute__((ext_vector_type(2)));
typedef __bf16 bf16x2q __attribute__((ext_vector_type(2)));
__device__ __forceinline__ unsigned pk2(float lo, float hi) { const f32x2q v = {lo, hi}; return __builtin_bit_cast(unsigned, __builtin_convertvector(v, bf16x2q)); }
__device__ __forceinline__ float bflo(unsigned w) { return __builtin_bit_cast(float, w << 16); }
__device__ __forceinline__ float bfhi(unsigned w) { return __builtin_bit_cast(float, w & 0xffff0000u); }
__device__ __forceinline__ float wave_sum(float v) { v += shx<1>(v); v += shx<2>(v); v += shx<4>(v); v += shx<8>(v); v += shx<16>(v); return sum32(v); }

constexpr int NB = 4, SEQ = 8192, DM = 1024, NTOK = NB * SEQ;
constexpr int NPROJ = 2048, WS5 = 512, NEXP = 32, NHEAD = 8;
constexpr int MAXRB = 544, MAXROWS = MAXRB * 256;
constexpr float RMS_EPS = 1e-6f;
constexpr float QSCALE = 4.0f * 0.17677669529663687f * 1.4426950408889634f;

constexpr size_t MiB = 1u << 20;
constexpr size_t WS_CTL = 0, CTL_ZERO_BYTES = 1 * MiB;
constexpr size_t WS_ABAR = 1 * MiB, WS_BBR = WS_ABAR + 65536, WS_BBI = WS_BBR + 262144, WS_SCAL = WS_BBI + 262144;
constexpr size_t WS_MODP = 2 * MiB;
constexpr size_t WS_TOPI = 4 * MiB, WS_GATE = WS_TOPI + 512 * 1024, WS_DEST = WS_GATE + 512 * 1024, WS_ROWTOK = WS_DEST + 512 * 1024, WS_ROWGATE = WS_ROWTOK + 640 * 1024;
constexpr size_t WS_CS = 3 * MiB + 512 * 1024;
constexpr size_t WS_MODF = 7 * MiB + 512 * 1024;
constexpr size_t WS_PARTS = 275 * MiB;
constexpr size_t WS_PARTX = 272 * MiB;
constexpr size_t WS_CNT = 7 * MiB, WS_BLKE = WS_CNT + 256 * 1024, WS_NRB = WS_BLKE + 64 * 1024, WS_RWT = WS_NRB + 64 * 1024;
constexpr size_t WS_W1T8 = 8 * MiB, WS_W2T8 = 72 * MiB, WS_H8 = 104 * MiB, WS_H = 200 * MiB;
constexpr size_t WS_WINT = 264 * MiB, WS_GLUT = 268 * MiB, WS_WOUTT = 269 * MiB, WS_PROJ = 272 * MiB, WS_YF = 400 * MiB, WS_YB = 464 * MiB;
constexpr size_t WS_MIXIN = 528 * MiB, WS_YSPRE = 592 * MiB, WS_ZG = 624 * MiB, WS_MIXO = 656 * MiB;
constexpr size_t WS_QG = 720 * MiB, WS_KG = 752 * MiB, WS_VTG = 784 * MiB, WS_UG = 816 * MiB;
constexpr size_t WS_XS8 = 264 * MiB, WS_ACT8 = 400 * MiB, WS_YS = 536 * MiB, WS_XMID = 848 * MiB, WS_END = 912 * MiB;
static_assert(WS_ROWGATE + MAXROWS * 4 <= WS_CNT && WS_ROWTOK + MAXROWS * 4 <= WS_ROWGATE, "routing tables");
static_assert(WS_XS8 + (size_t)MAXROWS * 1024 <= WS_ACT8 && WS_ACT8 + (size_t)MAXROWS * 1024 <= WS_YS && WS_YS + (size_t)MAXROWS * 1024 <= WS_END, "moe buffers");
constexpr float YSCALE = 16.0f;
constexpr float WSCALE = 32.0f;
constexpr int CW_BAR = 4096;

constexpr int RING_OFF = 0, RING_BYTES = 131072;
constexpr int LDSCTL_OFF = RING_BYTES, MISC_OFF = LDSCTL_OFF + 320;
constexpr int S5_URING_OFF = 147456;
constexpr int LDS_BYTES = 163840;

struct Params { const float* in[33]; float* out; unsigned char* ws; int ph_lo, ph_hi, li, pad; };

#define XB_TMO      128
#define XB_XCNT(j)  (256  + 64 * (j))
#define XB_XSUB(j)  (1280 + 64 * (j))
#define XB_XGEN(j)  (2304 + 64 * (j))
#define XB_TOP      3328
#define XB_TOPGEN   3392
#define XCD_BAR_WORDS 3456
#define XB_SPIN_CAP (1u << 18)

__device__ __forceinline__ unsigned xb_ld(unsigned* p)              { return __hip_atomic_load(p, __ATOMIC_RELAXED, __HIP_MEMORY_SCOPE_AGENT); }
__device__ __forceinline__ unsigned xb_add(unsigned* p, unsigned v) { return __hip_atomic_fetch_add(p, v, __ATOMIC_RELAXED, __HIP_MEMORY_SCOPE_AGENT); }
__device__ __forceinline__ unsigned xb_xcc_id() { return (unsigned)__builtin_amdgcn_s_getreg((3 << 11) | 20) & 0xFu; }
#define XB_SPIN(cond, bar) do { unsigned _sp = 0; while (cond) { __builtin_amdgcn_s_sleep(1); \
    if ((++_sp & 255u) == 0u) { if (xb_ld(&(bar)[XB_TMO])) break; if (_sp > XB_SPIN_CAP) { atomicAdd(&(bar)[XB_TMO], 1u); break; } } } } while (0)

struct XcdBarrier {
    unsigned* bar; unsigned x;
    volatile LAS unsigned* st;
};

__device__ __forceinline__ XcdBarrier xcd_barrier_post(const int wv_, unsigned* bar, volatile LAS unsigned* st) {
    XcdBarrier b; b.bar = bar; b.x = xb_xcc_id(); b.st = st;
    if (otid() == 0) (void)xb_add(&bar[XB_XCNT(b.x)], 1u);
    return b;
}
__device__ __forceinline__ void xcd_barrier_complete(unsigned* bar, unsigned x, unsigned& nloc, unsigned& nx) {
    const unsigned G = gridDim.x * gridDim.y * gridDim.z;
    unsigned sum, cnt, mine, sp = 0u;
    for (;;) {
        sum = 0u; cnt = 0u; mine = 0u;
#pragma unroll
        for (unsigned j = 0; j < 16; ++j) { const unsigned c = xb_ld(&bar[XB_XCNT(j)]); sum += c; cnt += (c > 0u) ? 1u : 0u; mine = (j == x) ? c : mine; }
        if (sum == G) break;
        __builtin_amdgcn_s_sleep(1);
        if ((++sp & 255u) == 0u) { if (xb_ld(&bar[XB_TMO])) break; if (sp > XB_SPIN_CAP) { atomicAdd(&bar[XB_TMO], 1u); break; } }
    }
    nloc = mine > 0u ? mine : 1u; nx = cnt > 0u ? cnt : 1u;
}

__device__ __forceinline__ void xcd_barrier(const int wv_, const XcdBarrier& b) {
    asm volatile("s_waitcnt vmcnt(0)" ::: "memory");
    __syncthreads();
    if (otid() == 0) {
        unsigned* bar = b.bar;
        __builtin_amdgcn_s_waitcnt(0);
        unsigned nloc = b.st[0], nx = b.st[1];
        if (nloc == 0u) { xcd_barrier_complete(bar, b.x, nloc, nx); b.st[0] = nloc; b.st[1] = nx; }
        const unsigned old = xb_add(&bar[XB_XSUB(b.x)], 1u);
        const unsigned gen = old / nloc;
        if (old + 1u == (gen + 1u) * nloc) {
            __builtin_amdgcn_fence(__ATOMIC_RELEASE, "agent");
            asm volatile("s_waitcnt vmcnt(0)" ::: "memory");
            const unsigned og = xb_add(&bar[XB_TOP], 1u);
            const unsigned tg = og / nx;
            if (og + 1u == (tg + 1u) * nx) xb_add(&bar[XB_TOPGEN], 1u);
            else XB_SPIN(xb_ld(&bar[XB_TOPGEN]) == tg, bar);
            __builtin_amdgcn_fence(__ATOMIC_ACQUIRE, "agent");
            xb_add(&bar[XB_XGEN(b.x)], 1u);
            asm volatile("s_waitcnt vmcnt(0)" ::: "memory");
        } else {
            XB_SPIN(xb_ld(&bar[XB_XGEN(b.x)]) == gen, bar);
            __builtin_amdgcn_fence(__ATOMIC_ACQUIRE, "agent");
            asm volatile("s_waitcnt vmcnt(0)" ::: "memory");
        }
    }
    __syncthreads();
}

__device__ __forceinline__ float silu_f(float v) { return v / (1.0f + __expf(-v)); }
__device__ __forceinline__ float mod_val(const Params& p, int b, int idx) {
    const float* modp = (const float*)(p.ws + WS_MODP); float s = p.in[4][idx];
#pragma unroll
    for (int ks = 0; ks < 16; ++ks) s += modp[(size_t)(ks * 4 + b) * 6144 + idx];
    return s;
}

__device__ __forceinline__ void p0_transpose_item(const float* W, int K, int N, bf16* WT, LAS float* scr, int item, int lane) {
    const int nblk = N / 32, kb = item / nblk, nb = item % nblk, k0 = 64 * kb, n0 = 32 * nb;
#pragma unroll 8
    for (int i = 0; i < 32; ++i) { const int kk = 2 * i + (lane >> 5); scr[kk * 33 + (lane & 31)] = __builtin_nontemporal_load(W + (size_t)(k0 + kk) * N + n0 + (lane & 31)); }
    LDS_WAIT(); asm volatile("" ::: "memory");
    const int c = lane & 7;
#pragma unroll
    for (int j = 0; j < 4; ++j) { const int n = (lane >> 3) + 8 * j; const LAS float* s = scr + (8 * c) * 33 + n;
        v4u o; o.x = pk2(s[0 * 33], s[1 * 33]); o.y = pk2(s[2 * 33], s[3 * 33]); o.z = pk2(s[4 * 33], s[5 * 33]); o.w = pk2(s[6 * 33], s[7 * 33]);
        *(v4u*)(WT + (size_t)(n0 + n) * K + k0 + 8 * c) = o; }
    LDS_WAIT(); asm volatile("" ::: "memory");
}

__device__ __forceinline__ void p0_transpose_item8(const float* W, int K, int N, unsigned char* WT8, LAS float* scr, int item, int lane, float scale) {
    const int nblk = N / 32, kb = item / nblk, nb = item % nblk, k0 = 64 * kb, n0 = 32 * nb;
    float wv[32];
#pragma unroll
    for (int i = 0; i < 32; ++i) wv[i] = __builtin_nontemporal_load(W + (size_t)(k0 + 2 * i + (lane >> 5)) * N + n0 + (lane & 31));
#pragma unroll
    for (int i = 0; i < 32; ++i) scr[(2 * i + (lane >> 5)) * 33 + (lane & 31)] = wv[i];
    LDS_WAIT(); asm volatile("" ::: "memory");
    const int c = lane & 7;
#pragma unroll
    for (int j = 0; j < 4; ++j) { const int n = (lane >> 3) + 8 * j; const LAS float* s = scr + (8 * c) * 33 + n;
        v2u o; o.x = pg8::pk4_fp8(s[0 * 33] * scale, s[1 * 33] * scale, s[2 * 33] * scale, s[3 * 33] * scale); o.y = pg8::pk4_fp8(s[4 * 33] * scale, s[5 * 33] * scale, s[6 * 33] * scale, s[7 * 33] * scale);
        *(v2u*)(WT8 + (size_t)(n0 + n) * K + k0 + 8 * c) = o; }
    LDS_WAIT(); asm volatile("" ::: "memory");
}

__device__ __forceinline__ void p0_transpose_item_rot(const float* W, int K, int N, bf16* WT, LAS float* scr, int item, int lane, const float* rowscale) {
    const int nblk = N / 32, kb = item / nblk, nb = item % nblk, k0 = 64 * kb, n0 = 32 * nb;
#pragma unroll 8
    for (int i = 0; i < 32; ++i) { const int kk = 2 * i + (lane >> 5), kp = k0 + kk; const int ks = (kp + 512) & 1023; const float sc = kp < 512 ? rowscale[kp] : 1.0f;
        scr[kk * 33 + (lane & 31)] = W[(size_t)ks * N + n0 + (lane & 31)] * sc; }
    LDS_WAIT(); asm volatile("" ::: "memory");
    const int c = lane & 7;
#pragma unroll
    for (int j = 0; j < 4; ++j) { const int n = (lane >> 3) + 8 * j; const LAS float* s = scr + (8 * c) * 33 + n;
        v4u o; o.x = pk2(s[0 * 33], s[1 * 33]); o.y = pk2(s[2 * 33], s[3 * 33]); o.z = pk2(s[4 * 33], s[5 * 33]); o.w = pk2(s[6 * 33], s[7 * 33]);
        *(v4u*)(WT + (size_t)(n0 + n) * K + k0 + 8 * c) = o; }
    LDS_WAIT(); asm volatile("" ::: "memory");
}

__device__ __forceinline__ void ph_prologue(const int wv_, const Params& p, LAS unsigned char* lds) {
    const int tid = otid(), lane = tid & 63, wave = tid >> 6, G = gridDim.x, bid = blockIdx.x;
    const int gw = bid * 8 + wave, NGW = G * 8;
    unsigned char* ws = p.ws;
    {
        const float* c = p.in[1]; const float* aw = p.in[3]; float* modp = (float*)(ws + WS_MODP);
        for (int it = gw; it < 1536; it += NGW) { const int cg = it % 96, ks = it / 96, j = cg * 64 + lane;
            float a0 = 0.f, a1 = 0.f, a2 = 0.f, a3 = 0.f;
#pragma unroll 8
            for (int kk = 0; kk < 64; ++kk) { const int k = ks * 64 + kk; const float w = aw[(size_t)k * 6144 + j];
                a0 += silu_f(c[k]) * w; a1 += silu_f(c[1024 + k]) * w; a2 += silu_f(c[2048 + k]) * w; a3 += silu_f(c[3072 + k]) * w; }
            modp[(size_t)(ks * 4 + 0) * 6144 + j] = a0; modp[(size_t)(ks * 4 + 1) * 6144 + j] = a1; modp[(size_t)(ks * 4 + 2) * 6144 + j] = a2; modp[(size_t)(ks * 4 + 3) * 6144 + j] = a3; }
    }
    {
        LAS float* scr = (LAS float*)(lds + RING_OFF + wave * 16384);
        constexpr int I_IN = 16 * 64, I_GLU = 8 * 16, I_OUT = 16 * 32, I_RW = 16, I_1 = 8 * 64, I_2 = 8 * 32;
        constexpr int NITEMS = I_IN + I_GLU + I_OUT + I_RW;
        for (int it = gw; it < NITEMS; it += NGW) {
            int r = it;
            if (r < I_IN) { p0_transpose_item8(p.in[6], 1024, 2048, ws + WS_WINT, scr, r, lane, WSCALE); continue; } r -= I_IN;
            if (r < I_GLU) { p0_transpose_item(p.in[22], 512, 512, (bf16*)(ws + WS_GLUT), scr, r, lane); continue; } r -= I_GLU;
            if (r < I_OUT) { p0_transpose_item_rot(p.in[25], 1024, 1024, (bf16*)(ws + WS_WOUTT), scr, r, lane, p.in[24]); continue; } r -= I_OUT;
            if (r < I_RW) { p0_transpose_item(p.in[27], 1024, 32, (bf16*)(ws + WS_RWT), scr, r, lane); continue; } r -= I_RW;
        }
    }
    {
        const int gt = bid * 512 + tid;
        if (gt < 4096) {
            const int dg = gt >> 6;
            const float lr = p.in[14][gt], li = p.in[15][gt], delta = expf(p.in[16][dg]);
            const float mag = expf(lr * delta), ar = mag * cosf(li * delta), ai = mag * sinf(li * delta);
            const float den = lr * lr + li * li, nr = ar - 1.0f, fr = (nr * lr + ai * li) / den, fi = (ai * lr - nr * li) / den;
            float* abar = (float*)(ws + WS_ABAR); float* bbr = (float*)(ws + WS_BBR); float* bbi = (float*)(ws + WS_BBI);
            abar[gt * 2] = ar; abar[gt * 2 + 1] = ai;
            for (int c = 0; c < 16; ++c) { const float br = p.in[17][gt * 16 + c], bi = p.in[18][gt * 16 + c];
                bbr[gt * 16 + c] = fr * br - fi * bi; bbi[gt * 16 + c] = fr * bi + fi * br; }
        }
        if (gt == 0) { float s1 = 0.f, s2 = 0.f;
            for (int i = 0; i < 32; ++i) { s1 += p.in[9][i] * p.in[10][i]; s2 += p.in[11][i] * p.in[12][i]; }
            ((float*)(ws + WS_SCAL))[0] = expf(s1) - expf(s2) + 0.2f; }
    }
}

__device__ __forceinline__ void ph_norm1(const int wv_, const Params& p, LAS unsigned char* lds) {
    const int tid = otid(), lane = tid & 63, wave = tid >> 6;
    LAS float* gs = (LAS float*)lds; LAS float* sh = gs + 1024;
    const float* x = p.in[0]; bf16* H = (bf16*)(p.ws + WS_H);
    for (int chunk = blockIdx.x; chunk < NTOK / 128; chunk += gridDim.x) {
        const int b = chunk / (SEQ / 128);
        for (int j = tid; j < 1024; j += 512) { gs[j] = p.in[5][j] * (1.0f + mod_val(p, b, 1024 + j)); sh[j] = mod_val(p, b, j); }
        if (chunk % (SEQ / 128) == 0) { float* modf = (float*)(p.ws + WS_MODF) + (size_t)b * 6144; for (int j = tid; j < 6144; j += 512) modf[j] = mod_val(p, b, j); }
        __syncthreads();
        f32x4 vn[4];
        { const f32x4* xr = (const f32x4*)(x + (size_t)(chunk * 128 + wave * 16) * DM) + lane;
#pragma unroll
          for (int j = 0; j < 4; ++j) vn[j] = xr[64 * j]; }
        for (int i = 0; i < 16; ++i) { const int row = chunk * 128 + wave * 16 + i;
            f32x4 v[4]; float ss = 0.f;
#pragma unroll
            for (int j = 0; j < 4; ++j) v[j] = vn[j];
            { const f32x4* xr = (const f32x4*)(x + (size_t)(row + (i < 15 ? 1 : 0)) * DM) + lane;
#pragma unroll
              for (int j = 0; j < 4; ++j) vn[j] = xr[64 * j]; }
#pragma unroll
            for (int j = 0; j < 4; ++j) ss += (v[j].x * v[j].x + v[j].y * v[j].y) + (v[j].z * v[j].z + v[j].w * v[j].w);
            if (lane < 4) { const float invf = lane == 0 ? 1.0f : (lane == 1 ? 0.037606030930863934f : (lane == 2 ? 0.0014142135623730951f : 5.3182958969449884e-05f));
                const float ang = (float)((const int*)p.in[2])[row] * invf; float* cs = (float*)(p.ws + WS_CS) + (size_t)row * 8; cs[lane] = cosf(ang); cs[4 + lane] = sinf(ang); }
            const float rstd = rsqrtf(wave_sum(ss) * (1.0f / DM) + RMS_EPS);
#pragma unroll
            for (int j = 0; j < 4; ++j) { const int c0 = 4 * lane + 256 * j; const f32x4 g4 = *(const LAS f32x4*)(gs + c0), s4 = *(const LAS f32x4*)(sh + c0);
                ((unsigned*)(p.ws + WS_H8) + (size_t)row * (DM / 4))[lane + 64 * j] = pg8::pk4_fp8(v[j].x * rstd * g4.x + s4.x, v[j].y * rstd * g4.y + s4.y, v[j].z * rstd * g4.z + s4.z, v[j].w * rstd * g4.w + s4.w); }
        }
        __syncthreads();
    }
}

__device__ __forceinline__ void ph_qkv_prep(const int wv_, const Params& p, LAS unsigned char* lds) {
    const bf16* PROJ = (const bf16*)(p.ws + WS_PROJ); const int* pos = (const int*)p.in[2];
    bf16* QG = (bf16*)(p.ws + WS_QG); bf16* KG = (bf16*)(p.ws + WS_KG); bf16* VTG = (bf16*)(p.ws + WS_VTG);
    const int gt = blockIdx.x * 512 + otid(), NT = gridDim.x * 512;
    for (int item = gt; item < NTOK * 32; item += NT) {
        const int tok = item >> 5, sub = item & 31, which = sub >> 4, hm = sub & 15;
        const v4u* ptr = (const v4u*)(PROJ + (size_t)tok * NPROJ + which * 512 + hm * 32);
        float v[32];
#pragma unroll
        for (int i = 0; i < 4; ++i) { const v4u w = ptr[i];
            v[8 * i + 0] = bflo(w.x); v[8 * i + 1] = bfhi(w.x); v[8 * i + 2] = bflo(w.y); v[8 * i + 3] = bfhi(w.y);
            v[8 * i + 4] = bflo(w.z); v[8 * i + 5] = bfhi(w.z); v[8 * i + 6] = bflo(w.w); v[8 * i + 7] = bfhi(w.w); }
        float ss = 0.f;
#pragma unroll
        for (int i = 0; i < 32; ++i) ss += v[i] * v[i];
        const float rstd = rsqrtf(ss * (1.0f / 32.0f) + RMS_EPS);
        const float* nw = which ? p.in[8] : p.in[7];
#pragma unroll
        for (int i = 0; i < 32; ++i) v[i] = v[i] * rstd * nw[i];
        const float fpos = (float)pos[tok];
        const float invf[4] = {1.0f, 0.037606030930863934f, 0.0014142135623730951f, 5.3182958969449884e-05f};
#pragma unroll
        for (int i = 0; i < 4; ++i) { const float ang = fpos * invf[i]; const float cs = cosf(ang), sn = sinf(ang);
            const float t1 = v[i], t2 = v[4 + i]; v[i] = t1 * cs - t2 * sn; v[4 + i] = t2 * cs + t1 * sn; }
        const float sc = which ? 1.0f : QSCALE;
        const int b = tok / SEQ, sq = tok % SEQ, hh = hm >> 1, mp = hm & 1;
        v4u* dst = (v4u*)((which ? KG : QG) + ((size_t)((b * NHEAD + hh) * SEQ + sq)) * 64 + mp * 32);
#pragma unroll
        for (int i = 0; i < 4; ++i) { v4u w;
            w.x = pk2(v[8 * i + 0] * sc, v[8 * i + 1] * sc); w.y = pk2(v[8 * i + 2] * sc, v[8 * i + 3] * sc);
            w.z = pk2(v[8 * i + 4] * sc, v[8 * i + 5] * sc); w.w = pk2(v[8 * i + 6] * sc, v[8 * i + 7] * sc); dst[i] = w; }
    }
    {
        bf16* UG = (bf16*)(p.ws + WS_UG);
        for (int item = gt; item < NTOK * 32; item += NT) { const int tok = item >> 5, g = item & 31, b = tok / SEQ, sq = tok % SEQ;
            const v4u* src = (const v4u*)(PROJ + (size_t)tok * NPROJ + 1536 + g * 16); v4u* dst = (v4u*)(UG + ((size_t)(b * 32 + g) * SEQ + sq) * 16);
            dst[0] = src[0]; dst[1] = src[1]; }
    }
    {
        const int lane = otid() & 63, wave = otid() >> 6;
        LAS unsigned short* T = (LAS unsigned short*)(lds + wave * 8448);
        for (int it = blockIdx.x * 8 + wave; it < NB * NHEAD * (SEQ / 64); it += gridDim.x * 8) {
            const int st = it % (SEQ / 64), h = (it / (SEQ / 64)) % NHEAD, b = it / ((SEQ / 64) * NHEAD);
            const v4u* src = (const v4u*)(PROJ + (size_t)(b * SEQ + st * 64 + lane) * NPROJ + 1024 + h * 64);
#pragma unroll
            for (int i = 0; i < 8; ++i) { const v4u w = src[i];
                T[(8 * i + 0) * 66 + lane] = (unsigned short)(w.x & 0xffffu); T[(8 * i + 1) * 66 + lane] = (unsigned short)(w.x >> 16);
                T[(8 * i + 2) * 66 + lane] = (unsigned short)(w.y & 0xffffu); T[(8 * i + 3) * 66 + lane] = (unsigned short)(w.y >> 16);
                T[(8 * i + 4) * 66 + lane] = (unsigned short)(w.z & 0xffffu); T[(8 * i + 5) * 66 + lane] = (unsigned short)(w.z >> 16);
                T[(8 * i + 6) * 66 + lane] = (unsigned short)(w.w & 0xffffu); T[(8 * i + 7) * 66 + lane] = (unsigned short)(w.w >> 16); }
            LDS_WAIT(); asm volatile("" ::: "memory");
            const LAS unsigned* row = (const LAS unsigned*)(T + lane * 66);
            v4u* dst = (v4u*)(VTG + ((size_t)((b * NHEAD + h) * 64 + lane)) * SEQ + st * 64);
#pragma unroll
            for (int i = 0; i < 8; ++i) { v4u w; w.x = row[4 * i]; w.y = row[4 * i + 1]; w.z = row[4 * i + 2]; w.w = row[4 * i + 3]; dst[i] = w; }
            LDS_WAIT(); asm volatile("" ::: "memory");
        }
    }
}

typedef short bf16x8 __attribute__((ext_vector_type(8)));
typedef float f32x16 __attribute__((ext_vector_type(16)));
__device__ __forceinline__ unsigned cvtpk(float lo, float hi) { unsigned r; asm("v_cvt_pk_bf16_f32 %0, %1, %2" : "=v"(r) : "v"(lo), "v"(hi)); return r; }
constexpr int ATT_NST = 4, ATT_STAGE = 32768, ATT_NT = SEQ / 128;
typedef float f32x2p __attribute__((ext_vector_type(2)));
typedef __bf16 bf16x2n __attribute__((ext_vector_type(2)));
__device__ __forceinline__ unsigned cvtpk2(float lo, float hi) { const f32x2p v = {lo, hi}; return __builtin_bit_cast(unsigned, __builtin_convertvector(v, bf16x2n)); }
typedef int i32x8a __attribute__((ext_vector_type(8)));
typedef int i32x4a __attribute__((ext_vector_type(4)));
typedef _Float16 f16x2a __attribute__((ext_vector_type(2)));
__device__ __forceinline__ int att_pk4b(float a, float b, float c, float d) {
    const unsigned h01 = __builtin_bit_cast(unsigned, __builtin_amdgcn_cvt_pkrtz(a, b)), h23 = __builtin_bit_cast(unsigned, __builtin_amdgcn_cvt_pkrtz(c, d));
    return (int)__builtin_amdgcn_perm(h23, h01, 0x07050301u); }
constexpr float ATT_MAGIC = 12582972.0f;
__device__ __forceinline__ int att_pk4c(float a, float b, float c, float d) {
    const unsigned lo = __builtin_amdgcn_perm(__builtin_bit_cast(unsigned, b), __builtin_bit_cast(unsigned, a), 0x0c0c0400u), hi = __builtin_amdgcn_perm(__builtin_bit_cast(unsigned, d), __builtin_bit_cast(unsigned, c), 0x0c0c0400u);
    return (int)((hi << 16) | lo); }
struct AttRegs { f32x16 S[2][2]; i32x8a P8; bf16x8 kf[2][2]; i32x8a vf8[2]; f32x16 L; i32x8a ones; int sc[2]; f32x16 CM; };
#define ATT_SB() __builtin_amdgcn_sched_barrier(0)
#ifdef ATT_USE_PRIO
#define ATT_PRIO(x) __builtin_amdgcn_s_setprio(x)
#else
#define ATT_PRIO(x) do { } while (0)
#endif
template <int ST, int I>
__device__ __forceinline__ void att_item(LAS unsigned char* lds, const unsigned koff0, const unsigned voff0, const bf16x8 (&qf)[2][2], f32x16 (&O)[2][2], AttRegs& R) {
    constexpr int m = I & 1, pm = m ^ 1;
    constexpr int J = I + 2, JST = (J >= 4) ? ((ST + 1) & 3) : ST, JG = (J & 3) >> 1, JM = J & 1;
#define CV(b, j) att_pk4c(R.S[m][b][j], R.S[m][b][j + 1], R.S[m][b][j + 2], R.S[m][b][j + 3])
    ATT_PRIO(1); O[pm][0] = __builtin_amdgcn_mfma_scale_f32_32x32x64_f8f6f4(R.vf8[0], R.P8, O[pm][0], 0, 1, 0, 0, 0, 0); ATT_PRIO(0);
    ATT_SB();
    ATT_PRIO(1); O[pm][1] = __builtin_amdgcn_mfma_scale_f32_32x32x64_f8f6f4(R.vf8[1], R.P8, O[pm][1], 0, 1, 0, 0, 0, 0); ATT_PRIO(0);
    R.L = __builtin_amdgcn_mfma_scale_f32_32x32x64_f8f6f4(R.ones, R.P8, R.L, 4, 1, 0, R.sc[pm], 0, 0x7f7f7f7f);
    if (m == 0) {
#pragma unroll
        for (int mt = 0; mt < 2; ++mt) {
            const i32x4a lo = *(const LAS i32x4a*)(lds + (voff0 ^ (unsigned)(((I >> 1) * 4 + 0) << 4)) + ST * ATT_STAGE + 16384 + mt * 4096);
            const i32x4a hi = *(const LAS i32x4a*)(lds + (voff0 ^ (unsigned)(((I >> 1) * 4 + 1) << 4)) + ST * ATT_STAGE + 16384 + mt * 4096);
            R.vf8[mt] = __builtin_shufflevector(lo, hi, 0, 1, 2, 3, 4, 5, 6, 7); } }
    ATT_SB();
    ATT_PRIO(1); R.S[pm][0] = __builtin_amdgcn_mfma_f32_32x32x16_bf16(R.kf[0][0], qf[pm][0], R.CM, 0, 0, 0); ATT_PRIO(0);
    R.P8[0] = CV(0, 0); R.P8[1] = CV(0, 4); ATT_SB();
    ATT_PRIO(1); R.S[pm][1] = __builtin_amdgcn_mfma_f32_32x32x16_bf16(R.kf[1][0], qf[pm][0], R.CM, 0, 0, 0); ATT_PRIO(0);
    R.P8[2] = CV(0, 8); R.P8[3] = CV(0, 12); ATT_SB();
    ATT_PRIO(1); R.S[pm][0] = __builtin_amdgcn_mfma_f32_32x32x16_bf16(R.kf[0][1], qf[pm][1], R.S[pm][0], 0, 0, 0); ATT_PRIO(0);
    R.P8[4] = CV(1, 0); R.P8[5] = CV(1, 4); ATT_SB();
    ATT_PRIO(1); R.S[pm][1] = __builtin_amdgcn_mfma_f32_32x32x16_bf16(R.kf[1][1], qf[pm][1], R.S[pm][1], 0, 0, 0); ATT_PRIO(0);
#pragma unroll
    for (int b_ = 0; b_ < 2; ++b_)
#pragma unroll
        for (int s_ = 0; s_ < 2; ++s_) R.kf[b_][s_] = *(const LAS bf16x8*)(lds + (koff0 ^ (unsigned)(((JM * 4 + 2 * s_) << 4))) + JST * ATT_STAGE + JG * 8192 + b_ * 2048);
    R.P8[6] = CV(1, 8); R.P8[7] = CV(1, 12); ATT_SB();
#undef CV
}
__device__ __forceinline__ void ph_attn(const int wv_, const Params& p, LAS unsigned char* lds) {
    const bf16* QG = (const bf16*)(p.ws + WS_QG); const bf16* KG = (const bf16*)(p.ws + WS_KG); const unsigned char* VTG8 = p.ws + WS_VTG; bf16* MIXIN = (bf16*)(p.ws + WS_MIXIN);
#define ATT_DMA(st) do { \
        __builtin_amdgcn_global_load_lds((const unsigned*)kptr, (LAS unsigned*)(lds + (st) * ATT_STAGE + ldsw), 16, 0, 0); \
        __builtin_amdgcn_global_load_lds((const unsigned*)(kptr + 8192), (LAS unsigned*)(lds + (st) * ATT_STAGE + 8192 + ldsw), 16, 0, 0); \
        __builtin_amdgcn_global_load_lds((const unsigned*)vptr, (LAS unsigned*)(lds + (st) * ATT_STAGE + 16384 + ldsw), 16, 0, 0); kptr += 16384; vptr += 128; } while (0)
#define ATT_TILE(ST) do { \
        att_item<ST, 0>(lds, koff0, voff0, qf, O, R); att_item<ST, 1>(lds, koff0, voff0, qf, O, R); \
        asm volatile("s_waitcnt vmcnt(3)" ::: "memory"); __builtin_amdgcn_s_barrier(); asm volatile("" ::: "memory"); \
        ATT_DMA(((ST) + 3) & 3); ATT_SB(); \
        att_item<ST, 2>(lds, koff0, voff0, qf, O, R); att_item<ST, 3>(lds, koff0, voff0, qf, O, R); } while (0)
    for (int i = 0;; ++i) {
        const int L = i * gridDim.x + blockIdx.x; if (L >= NB * NHEAD * (SEQ / 256)) break;
        const int bh = (L >> 8) * 8 + (L & 7), qb = (L >> 3) & 31;
        f32x16 O[2][2]; float lsum0, lsum1;
        {
            int tidu = otid(); asm volatile("" : "+v"(tidu));
            const int lane = tidu & 63, wave = __builtin_amdgcn_readfirstlane(tidu >> 6), r = lane & 31, h2 = lane >> 5;
            const int krow = tidu >> 3, kch = (tidu & 7) ^ ((krow >> 1) & 7);
            const char* kptr = (const char*)(KG + (size_t)bh * SEQ * 64) + (unsigned)(krow * 128 + kch * 16);
            const char* vptr = (const char*)(VTG8 + (size_t)bh * 64 * SEQ) + (unsigned)(krow * SEQ + kch * 16);
            const int kap = 32 * ((r >> 2) & 1) + 4 * (r >> 3) + (r & 3);
            const unsigned koff0 = (unsigned)(kap * 128 + ((h2 ^ ((kap >> 1) & 7)) << 4));
            const unsigned voff0 = (unsigned)(r * 128 + (((2 * h2) ^ ((r >> 1) & 7)) << 4));
            const unsigned ldsw = (unsigned)wave * 1024u;
            bf16x8 qf[2][2];
            { const bf16* qp = QG + ((size_t)bh * SEQ + qb * 256 + wave * 32 + r) * 64;
#pragma unroll
              for (int m = 0; m < 2; ++m)
#pragma unroll
                  for (int s = 0; s < 2; ++s) qf[m][s] = *(const bf16x8*)(qp + m * 32 + s * 16 + h2 * 8); }
            AttRegs R; R.P8 = (i32x8a){0, 0, 0, 0, 0, 0, 0, 0};
#pragma unroll
            for (int j = 0; j < 16; ++j) R.L[j] = 0.f;
            R.ones = (i32x8a){0x22222222, 0x22222222, 0x22222222, 0x22222222, 0, 0, 0, 0};
            { float mg_ = ATT_MAGIC; asm volatile("" : "+v"(mg_));
#pragma unroll
              for (int j = 0; j < 16; ++j) R.CM[j] = mg_;
              asm volatile("" : "+v"(R.CM)); }
            R.sc[0] = (r < 16) ? 0x7f7f7f7f : 0; R.sc[1] = (r < 16) ? 0 : 0x7f7f7f7f;
#pragma unroll
            for (int m = 0; m < 2; ++m) {
#pragma unroll
                for (int mt = 0; mt < 2; ++mt)
#pragma unroll
                    for (int j = 0; j < 16; ++j) O[m][mt][j] = 0.f;
                R.vf8[m] = (i32x8a){0, 0, 0, 0, 0, 0, 0, 0};
            }
            ATT_DMA(0); ATT_DMA(1); ATT_DMA(2);
            asm volatile("s_waitcnt vmcnt(6)" ::: "memory"); __builtin_amdgcn_s_barrier(); asm volatile("" ::: "memory");
#pragma unroll
            for (int b_ = 0; b_ < 2; ++b_)
#pragma unroll
                for (int s_ = 0; s_ < 2; ++s_) R.kf[b_][s_] = *(const LAS bf16x8*)(lds + (koff0 ^ (unsigned)((2 * s_) << 4)) + b_ * 2048);
            {
#pragma unroll
              for (int b_ = 0; b_ < 2; ++b_) { const f32x16 z_ = __builtin_amdgcn_mfma_f32_32x32x16_bf16(R.kf[b_][0], qf[0][0], R.CM, 0, 0, 0); R.S[0][b_] = __builtin_amdgcn_mfma_f32_32x32x16_bf16(R.kf[b_][1], qf[0][1], z_, 0, 0, 0); } }
            ATT_SB();
#pragma unroll
            for (int b_ = 0; b_ < 2; ++b_)
#pragma unroll
                for (int s_ = 0; s_ < 2; ++s_) R.kf[b_][s_] = *(const LAS bf16x8*)(lds + (koff0 ^ (unsigned)((4 + 2 * s_) << 4)) + b_ * 2048);
            ATT_SB();
            for (int t = 0; t < ATT_NT; t += 4) { ATT_TILE(0); ATT_TILE(1); ATT_TILE(2); ATT_TILE(3); }
            O[1][0] = __builtin_amdgcn_mfma_scale_f32_32x32x64_f8f6f4(R.vf8[0], R.P8, O[1][0], 0, 1, 0, 0, 0, 0);
            O[1][1] = __builtin_amdgcn_mfma_scale_f32_32x32x64_f8f6f4(R.vf8[1], R.P8, O[1][1], 0, 1, 0, 0, 0, 0);
            { int o1_ = 0x22222222; asm volatile("" : "+v"(o1_)); const i32x8a onesd = {o1_, o1_, o1_, o1_, 0, 0, 0, 0};
              int sc1_ = (otid() & 31) < 16 ? 0 : 0x7f7f7f7f;
              R.L = __builtin_amdgcn_mfma_scale_f32_32x32x64_f8f6f4(onesd, R.P8, R.L, 4, 1, 0, sc1_, 0, 0x7f7f7f7f); }
            lsum0 = R.L[0]; lsum1 = R.L[8];
            asm volatile("s_waitcnt vmcnt(0)" ::: "memory"); __builtin_amdgcn_s_barrier(); asm volatile("" ::: "memory");
        }
        int tide = otid(); asm volatile("" : "+v"(tide));
        const int r = tide & 31, h2 = (tide >> 5) & 1, wave = tide >> 6;
        const float lam = ((const float*)(p.ws + WS_SCAL))[0];
        const float r0 = 1.0f / lsum0, r1 = lam / lsum1; float ss = 0.f;
#pragma unroll
        for (int mt = 0; mt < 2; ++mt)
#pragma unroll
            for (int j = 0; j < 16; ++j) { const float o = O[0][mt][j] * r0 - O[1][mt][j] * r1; O[0][mt][j] = o; ss += o * o; }
        ss = sum32(ss);
        const float rstd = rsqrtf(ss * (1.0f / 64.0f) + RMS_EPS) * 0.8f;
        const int b = bh >> 3, hh = bh & 7, q = qb * 256 + wave * 32 + r;
        bf16* orow = MIXIN + (size_t)(b * SEQ + q) * DM + 512 + hh * 64;
#pragma unroll
        for (int mt = 0; mt < 2; ++mt)
#pragma unroll
            for (int a = 0; a < 4; ++a) { const int dv0 = 32 * mt + 8 * a + 4 * h2; const f32x4 sw = *(const f32x4*)(p.in[13] + dv0);
                v2u w; w.x = pk2(O[0][mt][4 * a + 0] * rstd * sw.x, O[0][mt][4 * a + 1] * rstd * sw.y); w.y = pk2(O[0][mt][4 * a + 2] * rstd * sw.z, O[0][mt][4 * a + 3] * rstd * sw.w);
                *(v2u*)(orow + dv0) = w; }
    }
#undef ATT_DMA
#undef ATT_TILE
}

typedef float f32x4m __attribute__((ext_vector_type(4)));
constexpr int CV_PAIRS = NEXP * (8 * 64 + 8 * 32);
struct CvCtx { int gw, ngw, nslots, slot, pend; unsigned char* dst; LAS float* scr; };
__device__ __forceinline__ void cv_issue(const Params& p, CvCtx& cv, int lane) {
    const int pair = (cv.slot >> 1) * cv.ngw + cv.gw, hk = cv.slot & 1; ++cv.slot;
    if (pair >= CV_PAIRS) return;
    const bool m1 = pair < NEXP * 512;
    int lgN, k0, n0; unsigned so;
    if (m1) { const int e = pair >> 9, q = pair & 511; cv.dst = p.ws + WS_W1T8 + (size_t)e * 2048 * 1024; lgN = 11; k0 = 64 * (2 * (q >> 6) + hk); n0 = 32 * (q & 63); so = (unsigned)e * (1024u * 2048u * 4u); }
    else { const int r = pair - NEXP * 512, e = r >> 8, q = r & 255; cv.dst = p.ws + WS_W2T8 + (size_t)e * 1024 * 1024; lgN = 10; k0 = 64 * (2 * (q >> 5) + hk); n0 = 32 * (q & 31); so = (unsigned)e * (1024u * 1024u * 4u); }
    cv.dst += (size_t)n0 * 1024 + k0;
    so += ((unsigned)k0 << (lgN + 2)) + (unsigned)n0 * 4u;
    const __amdgpu_buffer_rsrc_t rs = __builtin_amdgcn_make_buffer_rsrc((void*)(m1 ? p.in[29] : p.in[31]), 0, 0x7fffffff, 0x00020000);
    const unsigned vrow = (unsigned)(lane >> 3) << (lgN + 2), l7 = (unsigned)(lane & 7) << 4;
#pragma unroll
    for (int i = 0; i < 8; ++i)
        __builtin_amdgcn_raw_ptr_buffer_load_lds(rs, (LAS void*)((LAS char*)cv.scr + i * 1024), 16, (int)(vrow + (l7 ^ (unsigned)(i << 4))), (int)(so + ((unsigned)(8 * i) << (lgN + 2))), 0, 2);
    cv.pend = 1;
}
template <int VMC>
__device__ __forceinline__ void cv_finish(CvCtx& cv, int lane) {
    asm volatile("s_waitcnt vmcnt(%0)" :: "n"(VMC) : "memory");
    const int c = lane & 7;
#pragma unroll 1
    for (int j = 0; j < 4; ++j) { const int n = (lane >> 3) + 8 * j; float sv[8];
        const LAS float* q0 = cv.scr + (8 * c) * 32 + (((n >> 2) ^ c) << 2) + (n & 3);
#pragma unroll
        for (int q = 0; q < 8; ++q) sv[q] = q0[q * 32];
        asm volatile("" : "+v"(sv[0]), "+v"(sv[1]), "+v"(sv[2]), "+v"(sv[3]), "+v"(sv[4]), "+v"(sv[5]), "+v"(sv[6]), "+v"(sv[7]));
#pragma unroll
        for (int q = 0; q < 8; ++q) sv[q] *= WSCALE;
        v2u o; o.x = pg8::pk4_fp8(sv[0], sv[1], sv[2], sv[3]); o.y = pg8::pk4_fp8(sv[4], sv[5], sv[6], sv[7]);
        *(v2u*)(cv.dst + (size_t)n * 1024 + 8 * c) = o; }
    LDS_WAIT(); asm volatile("" ::: "memory");
    cv.pend = 0;
}
template <bool OUT>
__device__ __forceinline__ void s5_pass(LAS unsigned char* xt, const __amdgpu_buffer_rsrc_t urs, const unsigned ubyte0, LAS unsigned char* uring, bf16* Yb, int di, int lane, int wave, const bf16x8 (&bfr)[4], const bf16x8 (&cfr)[4],
                                        const float (&ar)[2], const float (&ai)[2], float (&xr)[2], float (&xi)[2], const Params& p, CvCtx& cv) {
    const int n = lane & 31, h = lane >> 5;
    const int m = lane & 31, hh = (m >> 2) & 1, tokin = 4 * (m >> 3) + (m & 3);
    const int ubase_tok = (2 * wave + hh) * 512 + tokin;
#define S5_UDMA(tn_, slot_) do { const int tp_ = ubase_tok + 16 * (tn_); \
        __builtin_amdgcn_raw_ptr_buffer_load_lds(urs, (LAS void*)(uring + (slot_) * 1024), 16, (int)(ubyte0 + (unsigned)(di ? (SEQ - 1 - tp_) : tp_) * 32u), 0, 0, 0); } while (0)
    S5_UDMA(0, 0); S5_UDMA(1, 1);
    asm volatile("s_waitcnt vmcnt(1)" ::: "memory");
    for (int t = 0; t < 32; ++t) {
        asm volatile("s_waitcnt vmcnt(%0)" :: "n"(OUT ? 3 : 1) : "memory");
        const bf16x8 uf = *(const LAS bf16x8*)(uring + (t & 1) * 1024 + lane * 16);
        LDS_WAIT(); asm volatile("" ::: "memory");
        if (cv.pend) cv_finish<OUT ? 3 : 1>(cv, lane);
        else if ((0x29 >> (t & 7)) & 1) { if (cv.slot < cv.nslots) cv_issue(p, cv, lane); }
        asm volatile("" ::: "memory");
        S5_UDMA((t + 2 < 32) ? t + 2 : 31, t & 1);
        asm volatile("" ::: "memory");
        f32x16 acc[4];
#pragma unroll
        for (int j = 0; j < 4; ++j) { f32x16 z = {0.f, 0.f, 0.f, 0.f, 0.f, 0.f, 0.f, 0.f, 0.f, 0.f, 0.f, 0.f, 0.f, 0.f, 0.f, 0.f}; acc[j] = __builtin_amdgcn_mfma_f32_32x32x16_bf16(uf, bfr[j], z, 0, 0, 0); }
#pragma unroll
        for (int i = 0; i < 16; ++i)
#pragma unroll
            for (int s = 0; s < 2; ++s) {
                const float nr = fmaf(ar[s], xr[s], fmaf(-ai[s], xi[s], acc[2 * s][i]));
                const float ni = fmaf(ar[s], xi[s], fmaf(ai[s], xr[s], acc[2 * s + 1][i]));
                xr[s] = nr; xi[s] = ni; acc[2 * s][i] = nr; acc[2 * s + 1][i] = ni; }
        if (OUT) {
#pragma unroll
            for (int i = 0; i < 16; ++i)
#pragma unroll
                for (int s = 0; s < 2; ++s) { const int c = (n >> 2) + 8 * s;
                    *(LAS unsigned*)(xt + h * 4096 + i * 256 + ((c ^ i) * 16) + (n & 3) * 4) = cvtpk(acc[2 * s][i], acc[2 * s + 1][i]); }
            const int row = lane & 15, kq = lane >> 4;
#pragma unroll
            for (int h2 = 0; h2 < 2; ++h2) { f32x4m y = {0.f, 0.f, 0.f, 0.f};
#pragma unroll
                for (int ks = 0; ks < 4; ++ks) { const bf16x8 af = *(const LAS bf16x8*)(xt + h2 * 4096 + row * 256 + (((ks * 4 + kq) ^ row) * 16));
                    y = __builtin_amdgcn_mfma_f32_16x16x32_bf16(af, cfr[ks], y, 0, 0, 0); }
                { const int tok0 = (2 * wave + h2) * 512 + 16 * t + 4 * kq; v2u w; int pos4;
                  if (!di) { pos4 = tok0 >> 2; w.x = cvtpk2(y[0], y[1]); w.y = cvtpk2(y[2], y[3]); } else { pos4 = (SEQ - 1 - tok0) >> 2; w.x = cvtpk2(y[3], y[2]); w.y = cvtpk2(y[1], y[0]); }
                  *(v2u*)(Yb + (size_t)pos4 * 64 + row * 4) = w; }
            }
        }
    }
#undef S5_UDMA
}
__device__ __forceinline__ void ph_s5(const int wv_, const Params& p, LAS unsigned char* lds) {
    const int tid = otid(), lane = tid & 63, wave = __builtin_amdgcn_readfirstlane(tid >> 6), n = lane & 31, h = lane >> 5;
    const bf16* UG = (const bf16*)(p.ws + WS_UG);
    const float* abar = (const float*)(p.ws + WS_ABAR); const float* bbr = (const float*)(p.ws + WS_BBR); const float* bbi = (const float*)(p.ws + WS_BBI);
    LAS unsigned char* xt = lds + wave * 8192; LAS float* Es = (LAS float*)(lds + 65536);
    CvCtx cv; cv.gw = blockIdx.x * 8 + wave; cv.ngw = gridDim.x * 8; cv.nslots = 2 * ((CV_PAIRS + cv.ngw - 1) / cv.ngw); cv.slot = 0; cv.pend = 0; cv.dst = p.ws;
    const __amdgpu_buffer_rsrc_t urs = __builtin_amdgcn_make_buffer_rsrc((void*)UG, 0, 0x7fffffff, 0x00020000);
    LAS unsigned char* uring = lds + S5_URING_OFF + wave * 2048;
    cv.scr = (LAS float*)(wave < 7 ? lds + 73728 + wave * 8192 : lds + LDSCTL_OFF + 4096);
    for (int u = blockIdx.x; u < NB * 32 * 2; u += gridDim.x) {
        const int di = u & 1, g = (u >> 1) & 31, b = u >> 6, dg = di * 32 + g;
        float ar[2], ai[2], a5r[2], a5i[2];
#pragma unroll
        for (int s = 0; s < 2; ++s) { const int sp = dg * 64 + n + 32 * s; ar[s] = abar[sp * 2]; ai[s] = abar[sp * 2 + 1];
            float pr = ar[s], pi = ai[s];
#pragma unroll
            for (int k = 0; k < 9; ++k) { const float nr = pr * pr - pi * pi, ni = 2.0f * pr * pi; pr = nr; pi = ni; }
            a5r[s] = pr; a5i[s] = pi; }
        bf16x8 bfr[4], cfr[4];
#pragma unroll
        for (int j = 0; j < 4; ++j) { const float* src = ((j & 1) ? bbi : bbr) + (size_t)(dg * 64 + n + 32 * (j >> 1)) * 16 + 8 * h;
            const f32x4 v0 = *(const f32x4*)src, v1 = *(const f32x4*)(src + 4);
            v4u w = {pk2(v0.x, v0.y), pk2(v0.z, v0.w), pk2(v1.x, v1.y), pk2(v1.z, v1.w)}; bfr[j] = __builtin_bit_cast(bf16x8, w); }
        { const int ch = lane & 15, kq = lane >> 4; const float* cre = p.in[19] + (size_t)(dg * 16 + ch) * 64; const float* cim = p.in[20] + (size_t)(dg * 16 + ch) * 64;
#pragma unroll
          for (int ks = 0; ks < 4; ++ks) { const int p0 = 16 * ks + 4 * kq; const f32x4 r4 = *(const f32x4*)(cre + p0), i4 = *(const f32x4*)(cim + p0);
              v4u w = {pk2(r4.x, -i4.x), pk2(r4.y, -i4.y), pk2(r4.z, -i4.z), pk2(r4.w, -i4.w)}; cfr[ks] = __builtin_bit_cast(bf16x8, w); } }
        const unsigned ubyte0 = (unsigned)(b * 32 + g) * (SEQ * 32u) + 16u * h;
        bf16* Yb = (bf16*)(p.ws + WS_YF) + ((size_t)((di * NB + b) * 32 + g)) * (SEQ / 4) * 64;
        float z0_ = 0.f; asm volatile("" : "+v"(z0_));
        float xr[2] = {z0_, z0_}, xi[2] = {z0_, z0_};
        s5_pass<false>(xt, urs, ubyte0, uring, Yb, di, lane, wave, bfr, cfr, ar, ai, xr, xi, p, cv);
        if (cv.pend) cv_finish<0>(cv, lane);
        const int sg = 2 * wave + h;
#pragma unroll
        for (int s = 0; s < 2; ++s) { Es[(sg * 64 + n + 32 * s) * 2] = xr[s]; Es[(sg * 64 + n + 32 * s) * 2 + 1] = xi[s]; }
        __syncthreads();
        float cr[2] = {z0_, z0_}, ci[2] = {z0_, z0_};
        for (int j = 0; j < 15; ++j) {
#pragma unroll
            for (int s = 0; s < 2; ++s) { const float er = Es[(j * 64 + n + 32 * s) * 2], ei = Es[(j * 64 + n + 32 * s) * 2 + 1];
                const float nr = a5r[s] * cr[s] - a5i[s] * ci[s] + er, ni = a5r[s] * ci[s] + a5i[s] * cr[s] + ei;
                cr[s] = (j < sg) ? nr : cr[s]; ci[s] = (j < sg) ? ni : ci[s]; } }
        __syncthreads();
        xr[0] = cr[0]; xr[1] = cr[1]; xi[0] = ci[0]; xi[1] = ci[1];
        s5_pass<true>(xt, urs, ubyte0, uring, Yb, di, lane, wave, bfr, cfr, ar, ai, xr, xi, p, cv);
        if (cv.pend) cv_finish<0>(cv, lane);
    }
    while (cv.slot < cv.nslots) { cv_issue(p, cv, lane); if (cv.pend) cv_finish<0>(cv, lane); }
}

__device__ __forceinline__ float gelu_tanh(float y) {
    const float z = 0.7978845608028654f * (y + 0.044715f * y * y * y);
    const float th = 1.0f - 2.0f * __builtin_amdgcn_rcpf(1.0f + __expf(2.0f * z));
    return 0.5f * y * (1.0f + th);
}
__device__ __forceinline__ void ph_s5_gelu(const int wv_, const Params& p) {
    const bf16* UG = (const bf16*)(p.ws + WS_UG); const bf16* YG = (const bf16*)(p.ws + WS_YF); bf16* YSPRE = (bf16*)(p.ws + WS_YSPRE);
    const int gt = blockIdx.x * 512 + otid(), NT = gridDim.x * 512;
    for (int it = gt; it < NB * 32 * (SEQ / 4) * 4; it += NT) {
        const int q = it & 3, g = (it >> 2) & 31, pos4 = (it >> 7) & (SEQ / 4 - 1), b = it >> 18;
        const size_t yo = ((size_t)(b * 32 + g) * (SEQ / 4) + pos4) * 64 + q * 16;
        const v4u f0 = __builtin_nontemporal_load((const v4u*)(YG + yo)), f1 = __builtin_nontemporal_load((const v4u*)(YG + yo + 8));
        const v4u r0 = __builtin_nontemporal_load((const v4u*)(YG + (size_t)NB * 32 * (SEQ / 4) * 64 + yo)), r1 = __builtin_nontemporal_load((const v4u*)(YG + (size_t)NB * 32 * (SEQ / 4) * 64 + yo + 8));
        const f32x4 d4 = *(const f32x4*)(p.in[21] + g * 16 + 4 * q);
        const unsigned fw[8] = {f0.x, f0.y, f0.z, f0.w, f1.x, f1.y, f1.z, f1.w}, rw[8] = {r0.x, r0.y, r0.z, r0.w, r1.x, r1.y, r1.z, r1.w};
        float yv[4][4];
#pragma unroll
        for (int cc = 0; cc < 4; ++cc) { yv[cc][0] = bflo(fw[2 * cc]) + bflo(rw[2 * cc]); yv[cc][1] = bfhi(fw[2 * cc]) + bfhi(rw[2 * cc]);
            yv[cc][2] = bflo(fw[2 * cc + 1]) + bflo(rw[2 * cc + 1]); yv[cc][3] = bfhi(fw[2 * cc + 1]) + bfhi(rw[2 * cc + 1]); }
#pragma unroll
        for (int t4 = 0; t4 < 4; ++t4) { const int sq = 4 * pos4 + t4;
            const v2u uw = *(const v2u*)(UG + ((size_t)(b * 32 + g) * SEQ + sq) * 16 + 4 * q);
            const float y0 = d4.x * bflo(uw.x) + yv[0][t4], y1 = d4.y * bfhi(uw.x) + yv[1][t4], y2 = d4.z * bflo(uw.y) + yv[2][t4], y3 = d4.w * bfhi(uw.y) + yv[3][t4];
            v2u o; o.x = pk2(gelu_tanh(y0), gelu_tanh(y1)); o.y = pk2(gelu_tanh(y2), gelu_tanh(y3));
            *(v2u*)(YSPRE + (size_t)(b * SEQ + sq) * WS5 + g * 16 + 4 * q) = o; }
    }
}
__device__ __forceinline__ void ph_s5_gate(const int wv_, const Params& p) {
    const bf16* YSPRE = (const bf16*)(p.ws + WS_YSPRE); const bf16* ZG = (const bf16*)(p.ws + WS_ZG); bf16* MIXIN = (bf16*)(p.ws + WS_MIXIN);
    const int lane = otid() & 63, gw = blockIdx.x * 8 + (otid() >> 6), NGW = gridDim.x * 8;
    const f32x4 w0 = *(const f32x4*)(p.in[24] + lane * 8), w1 = *(const f32x4*)(p.in[24] + lane * 8 + 4);
    for (int row = gw; row < NTOK; row += NGW) {
        const v4u yw = __builtin_nontemporal_load((const v4u*)(YSPRE + (size_t)row * WS5 + lane * 8)), zw = __builtin_nontemporal_load((const v4u*)(ZG + (size_t)row * WS5 + lane * 8));
        const float y[8] = {bflo(yw.x), bfhi(yw.x), bflo(yw.y), bfhi(yw.y), bflo(yw.z), bfhi(yw.z), bflo(yw.w), bfhi(yw.w)};
        const float z[8] = {bflo(zw.x), bfhi(zw.x), bflo(zw.y), bfhi(zw.y), bflo(zw.z), bfhi(zw.z), bflo(zw.w), bfhi(zw.w)};
        float s[8]; float ss = 0.f;
#pragma unroll
        for (int i = 0; i < 8; ++i) { s[i] = y[i] * __builtin_amdgcn_rcpf(1.0f + __expf(-z[i])); ss += s[i] * s[i]; }
        const float rstd = rsqrtf(wave_sum(ss) * (1.0f / WS5) + RMS_EPS);
        v4u o; o.x = pk2(s[0] * rstd * w0.x, s[1] * rstd * w0.y); o.y = pk2(s[2] * rstd * w0.z, s[3] * rstd * w0.w);
        o.z = pk2(s[4] * rstd * w1.x, s[5] * rstd * w1.y); o.w = pk2(s[6] * rstd * w1.z, s[7] * rstd * w1.w);
        *(v4u*)(MIXIN + (size_t)row * DM + 512 + lane * 8) = o;
    }
}

__device__ __forceinline__ void ph_mid(const int wv_, const Params& p, LAS unsigned char* lds) {
    const int tid = otid(), lane = tid & 63, wave = tid >> 6;
    LAS float* gs = (LAS float*)lds + 1024; LAS float* sh = gs + 1024; LAS int* cnt = (LAS int*)(sh + 1024);
    LAS float* lg = (LAS float*)(lds + 16384) + wave * (16 * 33);
    unsigned char* H8 = p.ws + WS_H8;
    const bf16* RWT = (const bf16*)(p.ws + WS_RWT); const float* rb = p.in[28];
    int* TOPI = (int*)(p.ws + WS_TOPI); float* GATE = (float*)(p.ws + WS_GATE); int* CNT = (int*)(p.ws + WS_CNT);
    for (int chunk = blockIdx.x; chunk < NTOK / 128; chunk += gridDim.x) {
        const int b = chunk / (SEQ / 128);
        { const float* modf = (const float*)(p.ws + WS_MODF) + (size_t)b * 6144; for (int j = tid; j < 1024; j += 512) { gs[j] = p.in[26][j] * (1.0f + modf[4096 + j]); sh[j] = modf[3072 + j]; } }
        if (tid < 32) cnt[tid] = 0;
        __syncthreads();
        const int row0 = chunk * 128 + wave * 16;
        const bf16* XM = (const bf16*)(p.ws + WS_XMID); const float* PARTX = (const float*)(p.ws + WS_PARTX);
        {
            const int rr = lane & 15, kq = lane >> 4; const int row = row0 + rr;
            float rstd;
            { const f32x4* px = (const f32x4*)(PARTX + (size_t)row * 16); const f32x4 p0 = px[0], p1 = px[1], p2 = px[2], p3 = px[3];
              const f32x4 ps = (p0 + p1) + (p2 + p3); rstd = rsqrtf(((ps.x + ps.y) + (ps.z + ps.w)) * (1.0f / DM) + RMS_EPS); }
            const bf16* xp = XM + (size_t)row * DM + kq * 8; unsigned char* h8p = H8 + (size_t)row * DM + kq * 8;
            const bf16* bp = RWT + (size_t)rr * DM + kq * 8; const LAS float* gp = gs + kq * 8; const LAS float* sp = sh + kq * 8;
            f32x4 a0 = {0.f, 0.f, 0.f, 0.f}, a1 = {0.f, 0.f, 0.f, 0.f};
#pragma unroll 8
            for (int ks = 0; ks < 32; ++ks) {
                const v4u xw = __builtin_nontemporal_load((const v4u*)(xp + ks * 32));
                const bf16x8 b0 = *(const bf16x8*)(bp + ks * 32), b1 = *(const bf16x8*)(bp + 16 * DM + ks * 32);
                const f32x4 g0 = *(const LAS f32x4*)(gp + ks * 32), g1 = *(const LAS f32x4*)(gp + ks * 32 + 4), s0 = *(const LAS f32x4*)(sp + ks * 32), s1 = *(const LAS f32x4*)(sp + ks * 32 + 4);
                const float h0 = bflo(xw.x) * rstd * g0.x + s0.x, h1 = bfhi(xw.x) * rstd * g0.y + s0.y, h2v = bflo(xw.y) * rstd * g0.z + s0.z, h3 = bfhi(xw.y) * rstd * g0.w + s0.w;
                const float h4 = bflo(xw.z) * rstd * g1.x + s1.x, h5 = bfhi(xw.z) * rstd * g1.y + s1.y, h6 = bflo(xw.w) * rstd * g1.z + s1.z, h7 = bfhi(xw.w) * rstd * g1.w + s1.w;
                const v4u hw = {pk2(h0, h1), pk2(h2v, h3), pk2(h4, h5), pk2(h6, h7)}; const bf16x8 af = __builtin_bit_cast(bf16x8, hw);
                v2u o8; o8.x = pg8::pk4_fp8(h0, h1, h2v, h3); o8.y = pg8::pk4_fp8(h4, h5, h6, h7); *(v2u*)(h8p + ks * 32) = o8;
                a0 = __builtin_amdgcn_mfma_f32_16x16x32_bf16(af, b0, a0, 0, 0, 0); a1 = __builtin_amdgcn_mfma_f32_16x16x32_bf16(af, b1, a1, 0, 0, 0); }
            const float rb0 = rb[rr], rb1 = rb[16 + rr];
#pragma unroll
            for (int rg = 0; rg < 4; ++rg) { lg[(4 * kq + rg) * 33 + rr] = a0[rg] + rb0; lg[(4 * kq + rg) * 33 + 16 + rr] = a1[rg] + rb1; }
        }
        LDS_WAIT(); asm volatile("" ::: "memory");
        if (lane < 16) {
            float l[32];
#pragma unroll
            for (int e = 0; e < 32; ++e) l[e] = lg[lane * 33 + e];
            int ti[4]; float tv[4];
#pragma unroll
            for (int k = 0; k < 4; ++k) { float best = -3.0e38f; int bi = 0;
#pragma unroll
                for (int e = 0; e < 32; ++e) { const bool take = l[e] > best; best = take ? l[e] : best; bi = take ? e : bi; }
                ti[k] = bi; tv[k] = best;
#pragma unroll
                for (int e = 0; e < 32; ++e) l[e] = (e == bi) ? -3.0e38f : l[e]; }
            const float e1 = __expf(tv[1] - tv[0]), e2 = __expf(tv[2] - tv[0]), e3 = __expf(tv[3] - tv[0]); const float inv = 1.0f / (1.0f + e1 + e2 + e3);
            const int row = row0 + lane;
            *(int4*)(TOPI + (size_t)row * 4) = make_int4(ti[0], ti[1], ti[2], ti[3]); *(f32x4*)(GATE + (size_t)row * 4) = (f32x4){inv, e1 * inv, e2 * inv, e3 * inv};
            atomicAdd((int*)(cnt + ti[0]), 1); atomicAdd((int*)(cnt + ti[1]), 1); atomicAdd((int*)(cnt + ti[2]), 1); atomicAdd((int*)(cnt + ti[3]), 1);
        }
        __syncthreads();
        if (tid < 32) CNT[chunk * 32 + tid] = cnt[tid];
        __syncthreads();
    }
}

__device__ __forceinline__ void ph_scatter(const int wv_, const Params& p, LAS unsigned char* lds) {
    const int tid = otid(), lane = tid & 63, wave = tid >> 6;
    LAS int* tot = (LAS int*)lds; LAS int* pst = tot + 32; LAS int* cur = pst + 32; LAS int* rowof = cur + 32  ; LAS int* pre = rowof + 512;
    const int* CNT = (const int*)(p.ws + WS_CNT); const int* TOPI = (const int*)(p.ws + WS_TOPI); const float* GATE = (const float*)(p.ws + WS_GATE);
    int* DEST = (int*)(p.ws + WS_DEST); int* ROWTOK = (int*)(p.ws + WS_ROWTOK); float* ROWGATE = (float*)(p.ws + WS_ROWGATE);
    int* BLKE = (int*)(p.ws + WS_BLKE); int* NRB = (int*)(p.ws + WS_NRB);
    const unsigned char* H8 = p.ws + WS_H8; unsigned char* XS8 = p.ws + WS_XS8;
    for (int chunk = blockIdx.x; chunk < NTOK / 128; chunk += gridDim.x) {
        {
          LAS int* ptl = pre + 32; const int e_ = tid & 31, cg = tid >> 5; int t = 0, pr = 0;
#pragma unroll
          for (int k = 0; k < 16; ++k) { const int c = cg * 16 + k; const int v = CNT[c * 32 + e_]; t += v; pr += (c < chunk) ? v : 0; }
          ptl[cg * 32 + e_] = t; ptl[512 + cg * 32 + e_] = pr;
          __syncthreads();
          if (tid < 32) { int ts = 0, ps = 0;
#pragma unroll
              for (int k = 0; k < 16; ++k) { ts += ptl[k * 32 + tid]; ps += ptl[512 + k * 32 + tid]; }
              tot[tid] = ts; pre[tid] = ps; } }
        __syncthreads();
        if (tid == 0) { int acc = 0; for (int e = 0; e < 32; ++e) { pst[e] = acc; cur[e] = acc + pre[e]; acc += ((tot[e] + 255) >> 8) << 8; }
            if (chunk == 0) { NRB[0] = acc >> 8; } }
        __syncthreads();
        if (chunk == 0) {
            const int nrb = (pst[31] + (((tot[31] + 255) >> 8) << 8)) >> 8;
            for (int rb = tid; rb < MAXRB; rb += 512) { int e = 31; for (int k = 0; k < 32; ++k) { if (rb * 256 < pst[k] + (((tot[k] + 255) >> 8) << 8)) { e = k; break; } } BLKE[rb] = (rb < nrb) ? e : 31; }
        }
        if (chunk < 32) {
            const int e = chunk, r0 = pst[e] + tot[e], r1 = pst[e] + (((tot[e] + 255) >> 8) << 8);
            for (int r = r0 + wave; r < r1; r += 8) { v4u z = {0u, 0u, 0u, 0u}; v4u* dst = (v4u*)(XS8 + (size_t)r * DM); dst[lane] = z; if (lane == 0) { ROWTOK[r] = -1; ROWGATE[r] = 0.f; } }
        }
        { const int tok = chunk * 128 + (tid >> 2), k = tid & 3; const int e = TOPI[tok * 4 + k];
          const int row = atomicAdd((int*)(cur + e), 1);
          DEST[tok * 4 + k] = row; ROWTOK[row] = tok; ROWGATE[row] = GATE[tok * 4 + k]; rowof[tid] = row; }
        __syncthreads();
        for (int a = wave * 64; a < wave * 64 + 64; ++a) { const int row = rowof[a], tok = chunk * 128 + (a >> 2);
            const v4u* src = (const v4u*)(H8 + (size_t)tok * DM); v4u* dst = (v4u*)(XS8 + (size_t)row * DM);
            dst[lane] = src[lane]; }
        __syncthreads();
    }
}

typedef float f32x2u __attribute__((ext_vector_type(2)));
__device__ __forceinline__ void ph_combine(const int wv_, const Params& p, LAS unsigned char* lds) {
    const int tid = otid(), lane = tid & 63, wave = tid >> 6;
    LAS float* g2 = (LAS float*)lds;
    const unsigned char* YS = p.ws + WS_YS; const int* DEST = (const int*)(p.ws + WS_DEST);
    for (int chunk = blockIdx.x; chunk < NTOK / 128; chunk += gridDim.x) {
        const int b = chunk / (SEQ / 128);
        for (int j = tid; j < 1024; j += 512) g2[j] = ((const float*)(p.ws + WS_MODF))[(size_t)b * 6144 + 5120 + j] * (1.0f / YSCALE);
        __syncthreads();
        const int rowb = chunk * 128 + wave * 16;
        unsigned yn[4][4]; v2u on[4]; int4 dn;
        { const int4 d4 = *(const int4*)(DEST + (size_t)rowb * 4); const int dd[4] = {d4.x, d4.y, d4.z, d4.w};
#pragma unroll
          for (int k = 0; k < 4; ++k) { const unsigned* yp = (const unsigned*)(YS + (size_t)dd[k] * DM) + lane;
#pragma unroll
              for (int j = 0; j < 4; ++j) yn[k][j] = __builtin_nontemporal_load(yp + 64 * j); }
          const v2u* orow = (const v2u*)((const bf16*)(p.ws + WS_XMID) + (size_t)rowb * DM) + lane;
#pragma unroll
          for (int j = 0; j < 4; ++j) on[j] = __builtin_nontemporal_load(orow + 64 * j);
          dn = *(const int4*)(DEST + (size_t)(rowb + 1) * 4); }
        for (int i = 0; i < 16; ++i) { const int row = rowb + i;
            unsigned yv[4][4]; v2u ov[4];
#pragma unroll
            for (int k = 0; k < 4; ++k)
#pragma unroll
                for (int j = 0; j < 4; ++j) yv[k][j] = yn[k][j];
#pragma unroll
            for (int j = 0; j < 4; ++j) ov[j] = on[j];
            { const int rn = row + (i < 15 ? 1 : 0); const int dd[4] = {dn.x, dn.y, dn.z, dn.w};
#pragma unroll
              for (int k = 0; k < 4; ++k) { const unsigned* yp = (const unsigned*)(YS + (size_t)dd[k] * DM) + lane;
#pragma unroll
                  for (int j = 0; j < 4; ++j) yn[k][j] = __builtin_nontemporal_load(yp + 64 * j); }
              const v2u* orn = (const v2u*)((const bf16*)(p.ws + WS_XMID) + (size_t)rn * DM) + lane;
#pragma unroll
              for (int j = 0; j < 4; ++j) on[j] = __builtin_nontemporal_load(orn + 64 * j);
              dn = *(const int4*)(DEST + (size_t)(row + (i < 14 ? 2 : (i < 15 ? 1 : 0))) * 4); }
            f32x4* orow = (f32x4*)(p.out + (size_t)row * DM) + lane;
#pragma unroll
            for (int j = 0; j < 4; ++j) { const int c0 = 4 * lane + 256 * j; const f32x4 gg = *(const LAS f32x4*)(g2 + c0);
                f32x2u lo = {0.f, 0.f}, hi = {0.f, 0.f};
#pragma unroll
                for (int k = 0; k < 4; ++k) { lo += __builtin_amdgcn_cvt_pk_f32_fp8((int)yv[k][j], false); hi += __builtin_amdgcn_cvt_pk_f32_fp8((int)yv[k][j], true); }
                f32x4 v = {bflo(ov[j].x), bfhi(ov[j].x), bflo(ov[j].y), bfhi(ov[j].y)}; v.x += gg.x * lo.x; v.y += gg.y * lo.y; v.z += gg.z * hi.x; v.w += gg.w * hi.y;
                __builtin_nontemporal_store(v, orow + 64 * j); }
        }
        __syncthreads();
    }
}

constexpr int N_PHASES = 15;
__global__ void __launch_bounds__(512, 2) fwd_kernel(Params p) {
    extern __shared__ __attribute__((aligned(16))) unsigned char lds_raw[];
    LAS unsigned char* lds = (LAS unsigned char*)lds_raw;
    const int wv_ = __builtin_amdgcn_readfirstlane(threadIdx.x >> 6);
    const int tid = otid();
    unsigned char* ws = p.ws;
    for (int u = tid; u < (LDS_BYTES - LDSCTL_OFF) / 4; u += 512) ((LAS unsigned*)(lds + LDSCTL_OFF))[u] = 0u;
    __syncthreads();
    const int lo = p.ph_lo, hi = p.ph_hi;
    XcdBarrier bar; bar.bar = (unsigned*)(ws + WS_CTL) + CW_BAR + p.li * XCD_BAR_WORDS; bar.x = 0; bar.st = nullptr;
    if (hi - lo > 1) bar = xcd_barrier_post(wv_, (unsigned*)(ws + WS_CTL) + CW_BAR + p.li * XCD_BAR_WORDS, (volatile LAS unsigned*)(lds + MISC_OFF) + 8);
#define IN(k) (lo <= (k) && (k) < hi)
#define SEAM(k) do { if (IN(k) && IN((k) + 1)) xcd_barrier(wv_, bar); } while (0)
#define SEAM2(k, k2) do { if (IN(k) && IN(k2)) xcd_barrier(wv_, bar); } while (0)

    if (IN(0)) { ph_prologue(wv_, p, lds); } SEAM(0);
    if (IN(1)) { ph_norm1(wv_, p, lds); } SEAM(1);
    if (IN(2)) {
        pg8::DenseSched S; S.o.init(NTOK / 256, NPROJ / 256, gridDim.x, blockIdx.x); S.A = (const char*)(ws + WS_H8); S.Bt = (const char*)(ws + WS_WINT); S.sideP = nullptr; S.side = nullptr; S.wv = wv_;
        pg8::EpiProj E{(pg8::bf16_t*)(ws + WS_QG), (pg8::bf16_t*)(ws + WS_KG), (pg8::bf16_t*)(ws + WS_VTG), (pg8::bf16_t*)(ws + WS_UG), p.in[7], p.in[8], (const float*)(ws + WS_CS), QSCALE, 1.0f / WSCALE};
        pg8::gemm_phase<pg8::EpiProj, pg8::DenseSched, true, true, true>(wv_, lds + RING_OFF, 512, S, E);
    } SEAM2(2, 4);
    {
        const bool s5_first = (blockIdx.x >> 3) & 1;
        if (IN(5) && s5_first) { ph_s5(wv_, p, lds); __syncthreads(); }
        if (IN(4)) { ph_attn(wv_, p, lds); }
        if (IN(5) && !s5_first) { __syncthreads(); ph_s5(wv_, p, lds); }
    }
    if ((IN(4) || IN(5)) && IN(6)) xcd_barrier(wv_, bar);
    if (IN(6)) { ph_s5_gelu(wv_, p); } SEAM(6);
    if (IN(7)) {
        pg8::DenseSched S; S.o.init(NTOK / 256, WS5 / 256, gridDim.x, blockIdx.x); S.A = (const char*)(ws + WS_YSPRE); S.Bt = (const char*)(ws + WS_GLUT); S.sideP = nullptr; S.side = nullptr; S.wv = wv_;
        pg8::EpiGlu E{(const pg8::bf16_t*)(ws + WS_YSPRE), p.in[23], (pg8::bf16_t*)(ws + WS_MIXIN), (float*)(ws + WS_PARTS)};
        pg8::gemm_phase<pg8::EpiGlu, pg8::DenseSched, true, true>(wv_, lds + RING_OFF, 512, S, E);
    } SEAM2(7, 9);
    if (IN(9)) {
        pg8::DenseSched S; S.o.init(NTOK / 256, DM / 256, gridDim.x, blockIdx.x); S.A = (const char*)(ws + WS_MIXIN); S.Bt = (const char*)(ws + WS_WOUTT); S.sideP = (const float*)(ws + WS_PARTS); S.side = lds + LDSCTL_OFF + 4096; S.wv = wv_;
        pg8::EpiXmid E{p.in[0], (const float*)(ws + WS_MODF) + 2048, (pg8::bf16_t*)(ws + WS_XMID), (float*)(ws + WS_PARTX), lds + LDSCTL_OFF + 4096};
        pg8::gemm_phase<pg8::EpiXmid, pg8::DenseSched, true, true>(wv_, lds + RING_OFF, 1024, S, E);
    } SEAM(9);
    if (IN(10)) { ph_mid(wv_, p, lds); } SEAM(10);
    if (IN(11)) { ph_scatter(wv_, p, lds); } SEAM(11);
    if (IN(12)) {
        const int nrb = __builtin_amdgcn_readfirstlane(*(const int*)(ws + WS_NRB));
        LAS int* ble = (LAS int*)(lds + LDSCTL_OFF + 2048); for (int j = otid(); j < MAXRB; j += 512) ble[j] = ((const int*)(ws + WS_BLKE))[j]; __syncthreads();
        pg8::GroupSched S; S.o.init(nrb, 2048 / 256, gridDim.x, blockIdx.x); S.A = (const char*)(ws + WS_XS8); S.W = (const char*)(ws + WS_W1T8); S.estride = (size_t)2048 * 1024; S.block_e = ble;
        S.bias = p.in[30]; S.bias_ld = 2048; S.rowgate = nullptr; S.side = lds + LDSCTL_OFF + 8192; S.wv = wv_;
        pg8::EpiSwiglu8 E{ws + WS_ACT8, lds + LDSCTL_OFF + 8192, 1.0f / WSCALE};
        pg8::gemm_phase<pg8::EpiSwiglu8, pg8::GroupSched, true, true, true>(wv_, lds + RING_OFF, 512, S, E);
    } SEAM(12);
    if (IN(13)) {
        const int nrb = __builtin_amdgcn_readfirstlane(*(const int*)(ws + WS_NRB));
        LAS int* ble = (LAS int*)(lds + LDSCTL_OFF + 2048); for (int j = otid(); j < MAXRB; j += 512) ble[j] = ((const int*)(ws + WS_BLKE))[j]; __syncthreads();
        pg8::GroupSched S; S.o.init(nrb, 1024 / 256, gridDim.x, blockIdx.x); S.A = (const char*)(ws + WS_ACT8); S.W = (const char*)(ws + WS_W2T8); S.estride = (size_t)1024 * 1024; S.block_e = ble;
        S.bias = p.in[32]; S.bias_ld = 1024; S.rowgate = (const float*)(ws + WS_ROWGATE); S.side = lds + LDSCTL_OFF + 8192; S.wv = wv_;
        pg8::EpiRowScale E{ws + WS_YS, lds + LDSCTL_OFF + 8192, 1.0f / WSCALE, YSCALE};
        pg8::gemm_phase<pg8::EpiRowScale, pg8::GroupSched, true, true, true>(wv_, lds + RING_OFF, 512, S, E);
    } SEAM(13);
    if (IN(14)) { ph_combine(wv_, p, lds); }
#undef IN
#undef SEAM
}

extern "C" void kernel_launch(void* const* d_in, const int* in_sizes, int n_in, void* d_out, int out_size, void* d_ws, size_t ws_size, hipStream_t stream) {
    static int grid = 0;
    if (grid == 0) {
        if (n_in != 33 || out_size != NTOK * DM || ws_size < WS_END) { fprintf(stderr, "kernel_launch: unexpected shapes (n_in %d out %d ws %zu)\n", n_in, out_size, ws_size); grid = -1; return; }
        int dev = 0, cus = 0, per_cu = 0;
        if (hipGetDevice(&dev) != hipSuccess || hipDeviceGetAttribute(&cus, hipDeviceAttributeMultiprocessorCount, dev) != hipSuccess) { grid = -1; return; }
        if (hipFuncSetAttribute((const void*)fwd_kernel, hipFuncAttributeMaxDynamicSharedMemorySize, LDS_BYTES) != hipSuccess) { fprintf(stderr, "kernel_launch: hipFuncSetAttribute failed\n"); grid = -1; return; }
        if (hipOccupancyMaxActiveBlocksPerMultiprocessor(&per_cu, (const void*)fwd_kernel, 512, LDS_BYTES) != hipSuccess || per_cu < 1) fprintf(stderr, "kernel_launch: occupancy query says %d\n", per_cu);
        (void)hipGetLastError();
        grid = cus;
    }
    if (grid < 0) return;
    if (hipMemsetAsync((char*)d_ws + WS_CTL, 0, CTL_ZERO_BYTES, stream) != hipSuccess) return;
    Params a{};
    for (int i = 0; i < 33; ++i) a.in[i] = (const float*)d_in[i];
    a.out = (float*)d_out; a.ws = (unsigned char*)d_ws;
#ifdef PROBE_REP
    a.ph_lo = 0; a.ph_hi = PROBE_REP + 1; a.li = 0; hipLaunchKernelGGL(fwd_kernel, dim3(grid), dim3(512), LDS_BYTES, stream, a);
    a.ph_lo = PROBE_REP; a.ph_hi = PROBE_REP + 1; a.li = 1; hipLaunchKernelGGL(fwd_kernel, dim3(grid), dim3(512), LDS_BYTES, stream, a);
    if (PROBE_REP + 1 < N_PHASES) { a.ph_lo = PROBE_REP + 1; a.ph_hi = N_PHASES; a.li = 2; hipLaunchKernelGGL(fwd_kernel, dim3(grid), dim3(512), LDS_BYTES, stream, a); }
#else
    a.ph_lo = 0; a.ph_hi = N_PHASES; a.li = 0; hipLaunchKernelGGL(fwd_kernel, dim3(grid), dim3(512), LDS_BYTES, stream, a);
#endif
}
```

```cpp
#include <hip/hip_runtime.h>
#include <cstdio>
#include <cstdint>

__device__ __forceinline__ int olane() { int t; asm volatile("v_mbcnt_lo_u32_b32 %0, -1, 0\n\tv_mbcnt_hi_u32_b32 %0, -1, %0" : "=v"(t)); return t; }
#define otid() ((wv_ << 6) | olane())
template <int M> __device__ __forceinline__ float shx(float v) { return __builtin_bit_cast(float, __builtin_amdgcn_ds_swizzle(__builtin_bit_cast(int, v), (M << 10) | 0x1f)); }
__device__ __forceinline__ float sum32(float v) { return v + __builtin_bit_cast(float, __builtin_amdgcn_ds_bpermute((olane() ^ 32) << 2, __builtin_bit_cast(int, v))); }
namespace pg8 {
#define PG8_LAS __attribute__((address_space(3)))
typedef unsigned short bf16_t;
typedef short bf16x8 __attribute__((ext_vector_type(8)));
typedef float f32x4 __attribute__((ext_vector_type(4)));
typedef unsigned u32x4 __attribute__((ext_vector_type(4)));
typedef unsigned u32x2 __attribute__((ext_vector_type(2)));
constexpr int BM = 256, BK = 64, HALF = 128, HTB = HALF * BK * 2  , STAGE_BYTES = 8 * HTB, NXCD = 8, WGM = 8;

__host__ __device__ __forceinline__ int lds_byte(int r, int c) { const int st = (r >> 4) * 2 + (c >> 5), rr = r & 15, cc = c & 31, ob = rr * 64 + cc * 2; return st * 1024 + (ob ^ (((ob >> 9) & 1) << 5)); }
__host__ __device__ __forceinline__ void stage_rc(int b, int& R, int& C) { const int st = b / 1024, sb = b % 1024, swz = sb ^ (((sb >> 9) & 1) << 5); R = (st >> 1) * 16 + swz / 64; C = (st & 1) * 32 + (swz % 64) / 2; }
__host__ __device__ __forceinline__ int perm32(int rho) { const int n = rho >> 4, i = rho & 15; return 8 * (i >> 2) + 4 * n + (i & 3); }

struct Unit { int pm, pn, e, slot; };

struct StaticOrder {
    int nM, nN, nwg, G, c;
    __host__ __device__ void init(int nM_, int nN_, int G_, int c_) { nM = nM_; nN = nN_; nwg = nM * nN; G = G_; c = c_; }
    __host__ __device__ bool next(int i, Unit& u) const {
        const long L = (long)i * G + c; if (L >= nwg) return false;
        int wgid = (int)L; { const int q = nwg / NXCD, r = nwg % NXCD, xcd = wgid % NXCD, off = wgid / NXCD; wgid = (xcd < r ? xcd * (q + 1) : r * (q + 1) + (xcd - r) * q) + off; }
        const int nig = WGM * nN, gid = wgid / nig, fm = gid * WGM, gsz = (nM - fm) < WGM ? (nM - fm) : WGM;
        u.pm = fm + ((wgid % nig) % gsz); u.pn = (wgid % nig) / gsz; u.e = 0; u.slot = i & 1; return true;
    }
};
struct DenseSched {
    StaticOrder o; const char* A; const char* Bt;
    const float* sideP; PG8_LAS unsigned char* side; int wv;
    __device__ __forceinline__ bool next(int i, Unit& u) const { return o.next(i, u); }
    __device__ __forceinline__ const char* a_base(const Unit& u, size_t tstep) const { return A + (size_t)u.pm * tstep; }
    __device__ __forceinline__ const char* b_base(const Unit& u, size_t tstep) const { return Bt + (size_t)u.pn * tstep; }
    __device__ __forceinline__ const char* a_root() const { return A; }
    __device__ __forceinline__ const char* b_root() const { return Bt; }
    __device__ __forceinline__ void a_ready(const Unit& u) const {
        if (sideP) __builtin_amdgcn_global_load_lds((const unsigned*)(sideP + (size_t)u.pm * 2048 + wv * 256 + olane() * 4), (PG8_LAS unsigned*)(side + wv * 1024), 16, 0, 0); }
    __device__ __forceinline__ void done(const Unit&) const {}
};
struct GroupSched {
    StaticOrder o; const char* A; const char* W; size_t estride; const PG8_LAS int* block_e;
    const float* bias; int bias_ld; const float* rowgate; PG8_LAS unsigned char* side; int wv;
    __device__ __forceinline__ bool next(int i, Unit& u) const { if (!o.next(i, u)) return false;
        if (rowgate) u.pm = o.nM - 1 - u.pm;
        u.e = __builtin_amdgcn_readfirstlane(block_e[u.pm]); return true; }
    __device__ __forceinline__ const char* a_base(const Unit& u, size_t tstep) const { return A + (size_t)u.pm * tstep; }
    __device__ __forceinline__ const char* b_base(const Unit& u, size_t tstep) const { return W + (size_t)u.e * estride + (size_t)u.pn * tstep; }
    __device__ __forceinline__ const char* a_root() const { return A; }
    __device__ __forceinline__ const char* b_root() const { return W; }
    __device__ __forceinline__ void a_ready(const Unit& u) const {
        const int ln = olane();
        if (wv == 0) __builtin_amdgcn_global_load_lds((const unsigned*)(bias + (size_t)u.e * bias_ld + u.pn * 256 + ln * 4), (PG8_LAS unsigned*)(side + u.slot * 2048), 16, 0, 0);
        if (wv == 1 && rowgate) __builtin_amdgcn_global_load_lds((const unsigned*)(rowgate + (size_t)u.pm * 256 + ln * 4), (PG8_LAS unsigned*)(side + u.slot * 2048 + 1024), 16, 0, 0);
    }
    __device__ __forceinline__ void done(const Unit&) const {}
};

__device__ __forceinline__ unsigned cvt_pk_bf16(float lo, float hi) { unsigned r; asm volatile("v_cvt_pk_bf16_f32 %0, %1, %2" : "=v"(r) : "v"(lo), "v"(hi)); return r; }

struct EpiBf16 {
    static constexpr bool PERM = true, AFTER_DRAIN = false, HAS_MID = false;
    bf16_t* O; int ldc; const float* bias;
    __device__ __forceinline__ void operator()(const f32x4 (&acc)[2][2][4][2], const Unit& u, int wr, int wc, int fr, int fq) const {
        const int row0 = u.pm * BM + wr * 64 + fr; const int col0 = u.pn * BM + wc * 32 + 8 * fq;
        f32x4 bv[2][2];
#pragma unroll
        for (int bj = 0; bj < 2; ++bj)
#pragma unroll
            for (int n = 0; n < 2; ++n) bv[bj][n] = bias ? *(const f32x4*)(bias + col0 + bj * HALF + 4 * n) : (f32x4){0.f, 0.f, 0.f, 0.f};
#pragma unroll
        for (int ai = 0; ai < 2; ++ai)
#pragma unroll
            for (int m = 0; m < 4; ++m) { bf16_t* rowp = O + (size_t)(row0 + ai * HALF + m * 16) * ldc + col0;
#pragma unroll
                for (int bj = 0; bj < 2; ++bj) { const f32x4 v0 = acc[ai][bj][m][0] + bv[bj][0], v1 = acc[ai][bj][m][1] + bv[bj][1];
                    u32x4 w; w.x = cvt_pk_bf16(v0[0], v0[1]); w.y = cvt_pk_bf16(v0[2], v0[3]); w.z = cvt_pk_bf16(v1[0], v1[1]); w.w = cvt_pk_bf16(v1[2], v1[3]);
                    *(u32x4*)(rowp + bj * HALF) = w; } }
    }
};

__device__ __forceinline__ unsigned pk4_fp8(float a, float b, float c, float d) { int r = __builtin_amdgcn_cvt_pk_fp8_f32(a, b, 0, false); r = __builtin_amdgcn_cvt_pk_fp8_f32(c, d, r, true); return (unsigned)r; }
struct EpiProj {
    static constexpr bool PERM = true, AFTER_DRAIN = false, HAS_MID = false;
    bf16_t *QG, *KG, *VTG, *UG; const float *qnw, *knw, *CS; float qscale, ascale;
    __device__ __forceinline__ void operator()(const f32x4 (&acc)[2][2][4][2], const Unit& u, int wr, int wc, int fr, int fq) const {
        constexpr int SEQ_ = 8192;
        const int row0 = u.pm * BM + wr * 64 + fr;
        if (u.pn < 4) {
            const bool isk = u.pn >= 2; const float* nw = (isk ? knw : qnw) + 8 * fq; bf16_t* dstb = isk ? KG : QG; const float sc = qscale;
            const f32x4 w0 = *(const f32x4*)nw, w1 = *(const f32x4*)(nw + 4);
#pragma unroll
            for (int ai = 0; ai < 2; ++ai)
#pragma unroll
                for (int m = 0; m < 4; ++m) { const int row = row0 + ai * HALF + m * 16, b = row / SEQ_, s = row % SEQ_;
                    const f32x4 c4 = *(const f32x4*)(CS + (size_t)row * 8), s4 = *(const f32x4*)(CS + (size_t)row * 8 + 4);
#pragma unroll
                    for (int bj = 0; bj < 2; ++bj) { const int hm = (u.pn & 1) * 8 + bj * 4 + wc;
                        const f32x4 v0 = acc[ai][bj][m][0] * ascale, v1 = acc[ai][bj][m][1] * ascale;
                        float ss = (v0[0] * v0[0] + v0[1] * v0[1]) + (v0[2] * v0[2] + v0[3] * v0[3]) + (v1[0] * v1[0] + v1[1] * v1[1]) + (v1[2] * v1[2] + v1[3] * v1[3]);
                        ss += shx<16>(ss); ss = sum32(ss);
                        const float rstd = rsqrtf(ss * (1.0f / 32.0f) + 1e-6f);
                        f32x4 y0 = v0 * rstd * w0, y1 = v1 * rstd * w1;
                        const f32x4 r0 = y0 * c4 - y1 * s4, r1 = y1 * c4 + y0 * s4;
                        if (fq == 0) { y0 = r0; y1 = r1; }
                        y0 = y0 * sc; y1 = y1 * sc;
                        unsigned qb[8];
#pragma unroll
                        for (int e = 0; e < 4; ++e) { qb[e] = __builtin_bit_cast(unsigned, __builtin_amdgcn_fmed3f(y0[e], -127.0f, 127.0f) + 12582912.0f); qb[4 + e] = __builtin_bit_cast(unsigned, __builtin_amdgcn_fmed3f(y1[e], -127.0f, 127.0f) + 12582912.0f); }
                        unsigned w0 = __builtin_amdgcn_perm(qb[1], qb[0], 0x0c0c0400u) | (__builtin_amdgcn_perm(qb[3], qb[2], 0x0c0c0400u) << 16), w1 = __builtin_amdgcn_perm(qb[5], qb[4], 0x0c0c0400u) | (__builtin_amdgcn_perm(qb[7], qb[6], 0x0c0c0400u) << 16);
                        unsigned* dq = (unsigned*)((unsigned char*)dstb + ((size_t)((b * 8 + (hm >> 1)) * SEQ_ + s)) * 64 + (hm & 1) * 32 + 8 * fq);
                        dq[0] = w0; dq[1] = w1; } }
        } else if (u.pn < 6) {
            const int ln_ = olane(); const unsigned s1_ = (ln_ & 1) ? 0x03070105u : 0x06020400u, s2_ = (ln_ & 2) ? 0x03020706u : 0x05040100u; const int j_ = ln_ & 3;
#pragma unroll
            for (int ai = 0; ai < 2; ++ai)
#pragma unroll
                for (int m = 0; m < 4; ++m) { const int row = row0 + ai * HALF + m * 16, b = row / SEQ_, s = row % SEQ_;
#pragma unroll
                    for (int bj = 0; bj < 2; ++bj) { const int h = 4 * (u.pn - 4) + 2 * bj + (wc >> 1), dv0 = (wc & 1) * 32 + 8 * fq;
                        unsigned char* pv = (unsigned char*)VTG + ((size_t)((b * 8 + h) * 64 + dv0 + j_)) * SEQ_ + (s - j_);
#pragma unroll
                        for (int n = 0; n < 2; ++n) { const f32x4 v = acc[ai][bj][m][n] * ascale; const unsigned a = pk4_fp8(v[0], v[1], v[2], v[3]);
                            const unsigned b1 = (unsigned)__builtin_amdgcn_update_dpp(0, (int)a, 0xB1, 0xF, 0xF, true);
                            const unsigned t = __builtin_amdgcn_perm(b1, a, s1_);
                            const unsigned c = (unsigned)__builtin_amdgcn_update_dpp(0, (int)t, 0x4E, 0xF, 0xF, true);
                            *(unsigned*)(pv + (size_t)(4 * n) * SEQ_) = __builtin_amdgcn_perm(c, t, s2_); } } }
        } else {
#pragma unroll
            for (int ai = 0; ai < 2; ++ai)
#pragma unroll
                for (int m = 0; m < 4; ++m) { const int row = row0 + ai * HALF + m * 16, b = row / SEQ_, s = row % SEQ_;
#pragma unroll
                    for (int bj = 0; bj < 2; ++bj) { const int g = 16 * (u.pn - 6) + 8 * bj + 2 * wc + (fq >> 1), ch0 = (fq & 1) * 8;
                        const f32x4 v0 = acc[ai][bj][m][0] * ascale, v1 = acc[ai][bj][m][1] * ascale;
                        u32x4 w; w.x = cvt_pk_bf16(v0[0], v0[1]); w.y = cvt_pk_bf16(v0[2], v0[3]); w.z = cvt_pk_bf16(v1[0], v1[1]); w.w = cvt_pk_bf16(v1[2], v1[3]);
                        *(u32x4*)(UG + ((size_t)((b * 32 + g) * SEQ_ + s)) * 16 + ch0) = w; } }
        }
    }
};

struct EpiGlu {
    static constexpr bool PERM = true, AFTER_DRAIN = false, HAS_MID = false;
    const bf16_t* YP; const float* bias; bf16_t* MIX; float* PART;
    __device__ __forceinline__ void operator()(const f32x4 (&acc)[2][2][4][2], const Unit& u, int wr, int wc, int fr, int fq) const {
        const int row0 = u.pm * BM + wr * 64 + fr; const int col0 = u.pn * BM + wc * 32 + 8 * fq;
        f32x4 bv[2][2];
#pragma unroll
        for (int bj = 0; bj < 2; ++bj)
#pragma unroll
            for (int n = 0; n < 2; ++n) bv[bj][n] = *(const f32x4*)(bias + col0 + bj * HALF + 4 * n);
#pragma unroll
        for (int ai = 0; ai < 2; ++ai)
#pragma unroll
            for (int m = 0; m < 4; ++m) { const int row = row0 + ai * HALF + m * 16; float ss = 0.f;
#pragma unroll
                for (int bj = 0; bj < 2; ++bj) { const u32x4 yw = *(const u32x4*)(YP + (size_t)row * 512 + col0 + bj * HALF);
                    const f32x4 z0 = acc[ai][bj][m][0] + bv[bj][0], z1 = acc[ai][bj][m][1] + bv[bj][1];
                    float s[8]; const unsigned yy[4] = {yw.x, yw.y, yw.z, yw.w};
#pragma unroll
                    for (int k = 0; k < 4; ++k) { const float zl = k < 2 ? z0[2 * k] : z1[2 * k - 4], zh = k < 2 ? z0[2 * k + 1] : z1[2 * k - 3];
                        s[2 * k] = __builtin_bit_cast(float, yy[k] << 16) * __builtin_amdgcn_rcpf(1.0f + __expf(-zl)); s[2 * k + 1] = __builtin_bit_cast(float, yy[k] & 0xffff0000u) * __builtin_amdgcn_rcpf(1.0f + __expf(-zh)); }
#pragma unroll
                    for (int k = 0; k < 8; ++k) ss += s[k] * s[k];
                    u32x4 w; w.x = cvt_pk_bf16(s[0], s[1]); w.y = cvt_pk_bf16(s[2], s[3]); w.z = cvt_pk_bf16(s[4], s[5]); w.w = cvt_pk_bf16(s[6], s[7]);
                    *(u32x4*)(MIX + (size_t)row * 1024 + col0 + bj * HALF) = w; }
                ss += shx<16>(ss); ss = sum32(ss);
                if (fq == 0) PART[(size_t)row * 8 + u.pn * 4 + wc] = ss; }
    }
};

struct EpiXmid {
    static constexpr bool PERM = true, AFTER_DRAIN = false, HAS_MID = true;
    const float* X; const float* G1; bf16_t* XM; float* PART; PG8_LAS unsigned char* side;
    __device__ __forceinline__ void mid(f32x4 (&acc)[2][2][4][2], const Unit& u, int wr, int wc, int fr, int fq) const {
#pragma unroll
        for (int ai = 0; ai < 2; ++ai)
#pragma unroll
            for (int m = 0; m < 4; ++m) { const PG8_LAS f32x4* pp = (const PG8_LAS f32x4*)(side + (ai * HALF + wr * 64 + m * 16 + fr) * 32); const f32x4 a = pp[0], b = pp[1];
                const float rs = rsqrtf((((a[0] + a[1]) + (a[2] + a[3])) + ((b[0] + b[1]) + (b[2] + b[3]))) * (1.0f / 512.0f) + 1e-6f);
#pragma unroll
                for (int bj = 0; bj < 2; ++bj)
#pragma unroll
                    for (int n = 0; n < 2; ++n) acc[ai][bj][m][n] = acc[ai][bj][m][n] * rs; }
    }
    __device__ __forceinline__ void operator()(const f32x4 (&acc)[2][2][4][2], const Unit& u, int wr, int wc, int fr, int fq) const {
        const int row0 = u.pm * BM + wr * 64 + fr; const int col0 = u.pn * BM + wc * 32 + 8 * fq; const int b = (u.pm * BM) / 8192;
        f32x4 gv[2][2];
#pragma unroll
        for (int bj = 0; bj < 2; ++bj)
#pragma unroll
            for (int n = 0; n < 2; ++n) gv[bj][n] = *(const f32x4*)(G1 + (size_t)b * 6144 + col0 + bj * HALF + 4 * n);
#pragma unroll
        for (int ai = 0; ai < 2; ++ai)
#pragma unroll
            for (int m = 0; m < 4; ++m) { const int row = row0 + ai * HALF + m * 16; const float* xr = X + (size_t)row * 1024 + col0; bf16_t* orow = XM + (size_t)row * 1024 + col0; float ss = 0.f;
#pragma unroll
                for (int bj = 0; bj < 2; ++bj) { const f32x4 x0 = *(const f32x4*)(xr + bj * HALF), x1 = *(const f32x4*)(xr + bj * HALF + 4);
                    const f32x4 v0 = x0 + gv[bj][0] * acc[ai][bj][m][0], v1 = x1 + gv[bj][1] * acc[ai][bj][m][1];
                    ss += (v0[0] * v0[0] + v0[1] * v0[1]) + (v0[2] * v0[2] + v0[3] * v0[3]) + (v1[0] * v1[0] + v1[1] * v1[1]) + (v1[2] * v1[2] + v1[3] * v1[3]);
                    u32x4 w; w.x = cvt_pk_bf16(v0[0], v0[1]); w.y = cvt_pk_bf16(v0[2], v0[3]); w.z = cvt_pk_bf16(v1[0], v1[1]); w.w = cvt_pk_bf16(v1[2], v1[3]);
                    *(u32x4*)(orow + bj * HALF) = w; }
                ss += shx<16>(ss); ss = sum32(ss);
                if (fq == 0) PART[(size_t)row * 16 + u.pn * 4 + wc] = ss; }
    }
};

__device__ __forceinline__ float swiglu_gate(float xg) { return xg * __builtin_amdgcn_rcpf(1.0f + __builtin_amdgcn_exp2f(-1.702f * 1.4426950408889634f * xg)); }
constexpr int SWG_TAB_OFF = 143360, SWG_SIDE_OFF = 131072 + 8192, SWG_TAB_N = 4097;
__device__ __forceinline__ void swiglu_table_fill(PG8_LAS unsigned char* lds0, int tid) {
    for (int i = tid; i < SWG_TAB_N; i += 512) ((PG8_LAS float*)(lds0 + SWG_TAB_OFF))[i] = swiglu_gate(fminf(-9.0f + (float)i * (1.0f / 256.0f), 7.0f));
}
__device__ __forceinline__ float swiglu1(PG8_LAS unsigned char* side, float g, float l1) {
    const unsigned bits = __builtin_bit_cast(unsigned, __builtin_fmaf(g, 1024.0f, 12582912.0f + 9216.0f + 2.0f));
    constexpr unsigned LO_ = 0x4B400000u, HI_ = 0x4B400000u + 4u * (SWG_TAB_N - 1) + 3u; const unsigned cl = bits < LO_ ? LO_ : (bits > HI_ ? HI_ : bits);
    const float f = *(const PG8_LAS float*)(side + (SWG_TAB_OFF - SWG_SIDE_OFF) + (cl & 0x7FFCu));
    return f * __builtin_amdgcn_fmed3f(l1, -6.0f, 8.0f);
}
struct EpiSwiglu8 {
    static constexpr bool PERM = true, AFTER_DRAIN = false, HAS_MID = false;
    unsigned char* O; PG8_LAS unsigned char* side; float ascale;
    __device__ __forceinline__ void operator()(const f32x4 (&acc)[2][2][4][2], const Unit& u, int wr, int wc, int fr, int fq) const {
        const int row0 = u.pm * BM + wr * 64 + fr; const int col0 = u.pn * BM + wc * 32 + 8 * fq;
        const PG8_LAS float* bias = (const PG8_LAS float*)(side + u.slot * 2048) + wc * 32 + 8 * fq;
        f32x4 bv[2][2];
#pragma unroll
        for (int bj = 0; bj < 2; ++bj)
#pragma unroll
            for (int n = 0; n < 2; ++n) { bv[bj][n] = *(const PG8_LAS f32x4*)(bias + bj * HALF + 4 * n); bv[bj][n].y += 1.0f; bv[bj][n].w += 1.0f; }
#pragma unroll
        for (int ai = 0; ai < 2; ++ai)
#pragma unroll
            for (int m = 0; m < 4; ++m) { unsigned char* rowp = O + (size_t)(row0 + ai * HALF + m * 16) * 1024 + (col0 >> 1);
#pragma unroll
                for (int bj = 0; bj < 2; ++bj) { const f32x4 v0 = acc[ai][bj][m][0] * ascale + bv[bj][0], v1 = acc[ai][bj][m][1] * ascale + bv[bj][1];
                    *(unsigned*)(rowp + bj * (HALF / 2)) = pk4_fp8(swiglu1(side, v0[0], v0[1]), swiglu1(side, v0[2], v0[3]), swiglu1(side, v1[0], v1[1]), swiglu1(side, v1[2], v1[3])); } }
    }
};
struct EpiRowScale {
    static constexpr bool PERM = true, AFTER_DRAIN = false, HAS_MID = false;
    unsigned char* O; PG8_LAS unsigned char* side; float ascale, oscale;
    __device__ __forceinline__ void operator()(const f32x4 (&acc)[2][2][4][2], const Unit& u, int wr, int wc, int fr, int fq) const {
        const int row0 = u.pm * BM + wr * 64 + fr; const int col0 = u.pn * BM + wc * 32 + 8 * fq;
        const PG8_LAS float* bias = (const PG8_LAS float*)(side + u.slot * 2048) + wc * 32 + 8 * fq; const PG8_LAS float* gates = (const PG8_LAS float*)(side + u.slot * 2048 + 1024) + wr * 64 + fr;
        f32x4 bv[2][2];
#pragma unroll
        for (int bj = 0; bj < 2; ++bj)
#pragma unroll
            for (int n = 0; n < 2; ++n) bv[bj][n] = *(const PG8_LAS f32x4*)(bias + bj * HALF + 4 * n);
#pragma unroll
        for (int ai = 0; ai < 2; ++ai)
#pragma unroll
            for (int m = 0; m < 4; ++m) { const int row = row0 + ai * HALF + m * 16; const float gt = gates[ai * HALF + m * 16] * oscale; unsigned char* rowp = O + (size_t)row * 1024 + col0;
#pragma unroll
                for (int bj = 0; bj < 2; ++bj) { const f32x4 v0 = (acc[ai][bj][m][0] * ascale + bv[bj][0]) * gt, v1 = (acc[ai][bj][m][1] * ascale + bv[bj][1]) * gt;
                    u32x2 w; w.x = pk4_fp8(v0[0], v0[1], v0[2], v0[3]); w.y = pk4_fp8(v1[0], v1[1], v1[2], v1[3]);
                    *(u32x2*)(rowp + bj * HALF) = w; } }
    }
};

#ifndef PG8_SCALE1
#define PG8_SCALE1 0
#endif
typedef int i32x4g __attribute__((ext_vector_type(4)));
typedef int i32x8g __attribute__((ext_vector_type(8)));
__device__ __forceinline__ i32x8g pg8_cat(bf16x8 lo, bf16x8 hi) { const i32x4g a = __builtin_bit_cast(i32x4g, lo), b = __builtin_bit_cast(i32x4g, hi); return __builtin_shufflevector(a, b, 0, 1, 2, 3, 4, 5, 6, 7); }
template <class Epi, class Sched, bool ALIGN_EPI = false, bool SP2 = false, bool FP8 = false>
__device__ __forceinline__ void gemm_phase(const int wv_, PG8_LAS unsigned char* lds, const int K, const Sched& S, const Epi& E) {
    const int tid = otid(), wid = __builtin_amdgcn_readfirstlane(tid >> 6), lane = tid & 63, wr = wid >> 2, wc = wid & 3, fr = lane & 15, fq = lane >> 4;
    const int nt = K / BK;
    unsigned voffA[2], voffB[2];
#pragma unroll
    for (int i = 0; i < 2; ++i) { int R, C; stage_rc(tid * 16 + i * 8192, R, C); const int Rb = Epi::PERM ? ((R & ~31) + perm32(R & 31)) : R;
        voffA[i] = (unsigned)(R * K + C) * 2u; voffB[i] = (unsigned)(Rb * K + C) * 2u; }
    const char* rootA = S.a_root(); const char* rootB = S.b_root();
    const __amdgpu_buffer_rsrc_t rsA = __builtin_amdgcn_make_buffer_rsrc((void*)rootA, 0, 0x7fffffff, 0x00020000), rsB = __builtin_amdgcn_make_buffer_rsrc((void*)rootB, 0, 0x7fffffff, 0x00020000);
    const size_t kstep = (size_t)(BK * 2);
    const size_t hstep = (size_t)HALF * K * 2;
    const size_t tstep = 2 * hstep;
    const unsigned ldsw = (unsigned)wid * 1024u;
    const int aoff = lds_byte(wr * 64 + fr, fq * 8), boff = lds_byte(wc * 32 + fr, fq * 8);
    constexpr int KOFF = 1024;
#define PG8_SA(b, h) (((b) * 2 + (h)) * HTB)
#define PG8_SB(b, h) ((4 + (b) * 2 + (h)) * HTB)
#define PG8_STAGE(bufoff, gbase, voff) do { const bool isA_ = (+(voff) == +voffA); const unsigned so_ = (unsigned)((gbase) - (isA_ ? rootA : rootB)); \
        _Pragma("unroll") for (int _i = 0; _i < 2; ++_i) __builtin_amdgcn_raw_ptr_buffer_load_lds(isA_ ? rsA : rsB, (PG8_LAS void*)(lds + (bufoff) + ldsw + _i * 8192), 16, (voff)[_i], so_, 0, 0); } while (0)
#define PG8_LDA(dst, b, h) do { _Pragma("unroll") for (int m = 0; m < 4; ++m) _Pragma("unroll") for (int k = 0; k < 2; ++k) dst[m][k] = *(const PG8_LAS bf16x8*)(lds + PG8_SA(b, h) + aoff + m * 2048 + k * KOFF); } while (0)
#define PG8_LDB(dst, b, h) do { _Pragma("unroll") for (int n = 0; n < 2; ++n) _Pragma("unroll") for (int k = 0; k < 2; ++k) dst[n][k] = *(const PG8_LAS bf16x8*)(lds + PG8_SB(b, h) + boff + n * 2048 + k * KOFF); } while (0)
#define PG8_MMA(ai, bj, At, Bt) do { __builtin_amdgcn_s_setprio(1); \
        if constexpr (FP8) { _Pragma("unroll") for (int m = 0; m < 4; ++m) _Pragma("unroll") for (int n = 0; n < 2; ++n) \
            acc[ai][bj][m][n] = __builtin_amdgcn_mfma_scale_f32_16x16x128_f8f6f4(pg8_cat(Bt[n][0], Bt[n][1]), pg8_cat(At[m][0], At[m][1]), acc[ai][bj][m][n], 0, 0, 0, PG8_SCALE1, 0, PG8_SCALE1); } \
        else { _Pragma("unroll") for (int m = 0; m < 4; ++m) _Pragma("unroll") for (int n = 0; n < 2; ++n) _Pragma("unroll") for (int k = 0; k < 2; ++k) \
            acc[ai][bj][m][n] = __builtin_amdgcn_mfma_f32_16x16x32_bf16(Bt[n][k], At[m][k], acc[ai][bj][m][n], 0, 0, 0); } __builtin_amdgcn_s_setprio(0); } while (0)
#define PG8_WAIT_V(n) asm volatile("s_waitcnt vmcnt(" #n ")" ::: "memory")
#define PG8_WAIT_L(n) asm volatile("s_waitcnt lgkmcnt(" #n ")" ::: "memory")
#define PG8_BAR __builtin_amdgcn_s_barrier()
#define PG8_SCHED __builtin_amdgcn_sched_barrier(0)
    Unit cur, nxt; int ui = 0;
    if (!S.next(0, cur)) return;
    f32x4 acc[2][2][4][2];
#pragma unroll
    for (int a = 0; a < 2; ++a)
#pragma unroll
        for (int b = 0; b < 2; ++b)
#pragma unroll
            for (int m = 0; m < 4; ++m)
#pragma unroll
                for (int n = 0; n < 2; ++n) acc[a][b][m][n] = (f32x4){0.f, 0.f, 0.f, 0.f};
    bf16x8 At[4][2], B0[2][2], B1[2][2];
    const char* cA = S.a_base(cur, tstep); const char* cB = S.b_base(cur, tstep);
    S.a_ready(cur);
    if constexpr (SP2) {
        PG8_STAGE(PG8_SB(0, 0), cB, voffB); PG8_STAGE(PG8_SB(0, 1), cB + hstep, voffB); PG8_STAGE(PG8_SA(0, 0), cA, voffA); PG8_STAGE(PG8_SA(0, 1), cA + hstep, voffA);
        if (wr == 1) PG8_BAR;
        PG8_WAIT_V(2); PG8_BAR;
        PG8_STAGE(PG8_SB(1, 0), cB + kstep, voffB); PG8_STAGE(PG8_SA(1, 0), cA + kstep, voffA); PG8_STAGE(PG8_SB(1, 1), cB + hstep + kstep, voffB);
        PG8_WAIT_V(6); PG8_BAR;
    } else {
        PG8_STAGE(PG8_SB(0, 0), cB, voffB); PG8_STAGE(PG8_SA(0, 0), cA, voffA); PG8_STAGE(PG8_SB(0, 1), cB + hstep, voffB); PG8_STAGE(PG8_SA(0, 1), cA + hstep, voffA);
        if (wr == 1) PG8_BAR;
        PG8_WAIT_V(4); PG8_BAR;
        PG8_STAGE(PG8_SB(1, 0), cB + kstep, voffB); PG8_STAGE(PG8_SA(1, 0), cA + kstep, voffA); PG8_STAGE(PG8_SB(1, 1), cB + hstep + kstep, voffB);
        PG8_WAIT_V(6); PG8_BAR;
    }
    for (;;) {
        const bool has_next = S.next(ui + 1, nxt);
        const char* nA = has_next ? S.a_base(nxt, tstep) : cA; const char* nB = has_next ? S.b_base(nxt, tstep) : cB;
#pragma unroll 1
        for (int t = 0; t < nt; t += 2) {
            const bool last = (t == nt - 2);
            const char* a1 = cA + (size_t)(t + 1) * kstep;
            const char* a2 = last ? nA : cA + (size_t)(t + 2) * kstep; const char* b2 = last ? nB : cB + (size_t)(t + 2) * kstep;
            const char* a3 = a2 + kstep; const char* b3 = b2 + kstep;
            if constexpr (Epi::HAS_MID) { if (t == nt / 2) { const int lm_ = olane(); E.mid(acc, cur, wr, wc, lm_ & 15, lm_ >> 4); } }
            if (last && has_next) S.a_ready(nxt);
            if constexpr (SP2) {
            PG8_LDB(B0, 0, 0); PG8_LDB(B1, 0, 1); PG8_SCHED; PG8_LDA(At, 0, 0); PG8_STAGE(PG8_SA(1, 1), a1 + hstep, voffA);
            PG8_WAIT_V(8); PG8_WAIT_L(0); PG8_BAR; PG8_MMA(0, 0, At, B0); PG8_MMA(0, 1, At, B1); PG8_BAR; PG8_SCHED;
            PG8_LDA(At, 0, 1); PG8_STAGE(PG8_SB(0, 0), b2, voffB); PG8_STAGE(PG8_SB(0, 1), b2 + hstep, voffB); PG8_STAGE(PG8_SA(0, 0), a2, voffA);
            PG8_WAIT_V(8); PG8_WAIT_L(0); PG8_BAR; PG8_MMA(1, 0, At, B0); PG8_MMA(1, 1, At, B1); PG8_BAR; PG8_SCHED;
            PG8_LDB(B0, 1, 0); PG8_LDB(B1, 1, 1); PG8_SCHED; PG8_LDA(At, 1, 0); PG8_STAGE(PG8_SA(0, 1), a2 + hstep, voffA);
            PG8_WAIT_V(8); PG8_WAIT_L(0); PG8_BAR; PG8_MMA(0, 0, At, B0); PG8_MMA(0, 1, At, B1); PG8_BAR; PG8_SCHED;
            PG8_LDA(At, 1, 1); PG8_STAGE(PG8_SB(1, 0), b3, voffB); PG8_STAGE(PG8_SB(1, 1), b3 + hstep, voffB); PG8_STAGE(PG8_SA(1, 0), a3, voffA);
            PG8_WAIT_V(8); PG8_WAIT_L(0); PG8_BAR; PG8_MMA(1, 0, At, B0); PG8_MMA(1, 1, At, B1); PG8_BAR; PG8_SCHED;
            } else {
            PG8_LDB(B0, 0, 0); PG8_SCHED; PG8_LDA(At, 0, 0); PG8_STAGE(PG8_SA(1, 1), a1 + hstep, voffA);
            PG8_WAIT_L(8); PG8_BAR; PG8_WAIT_L(0); PG8_MMA(0, 0, At, B0); PG8_BAR; PG8_SCHED;
            PG8_LDB(B1, 0, 1); PG8_STAGE(PG8_SB(0, 0), b2, voffB);
            PG8_BAR; PG8_WAIT_L(0); PG8_MMA(0, 1, At, B1); PG8_BAR;
            PG8_LDA(At, 0, 1); PG8_STAGE(PG8_SA(0, 0), a2, voffA);
            PG8_BAR; PG8_WAIT_L(0); PG8_MMA(1, 0, At, B0); PG8_BAR; PG8_SCHED;
            PG8_STAGE(PG8_SB(0, 1), b2 + hstep, voffB);
            PG8_WAIT_V(6); PG8_BAR; PG8_MMA(1, 1, At, B1); PG8_BAR;
            PG8_LDB(B0, 1, 0); PG8_SCHED; PG8_LDA(At, 1, 0); PG8_STAGE(PG8_SA(0, 1), a2 + hstep, voffA);
            PG8_WAIT_L(8); PG8_BAR; PG8_WAIT_L(0); PG8_MMA(0, 0, At, B0); PG8_BAR; PG8_SCHED;
            PG8_LDB(B1, 1, 1); PG8_STAGE(PG8_SB(1, 0), b3, voffB);
            PG8_BAR; PG8_WAIT_L(0); PG8_MMA(0, 1, At, B1); PG8_BAR;
            PG8_LDA(At, 1, 1); PG8_STAGE(PG8_SA(1, 0), a3, voffA);
            PG8_BAR; PG8_WAIT_L(0); PG8_MMA(1, 0, At, B0); PG8_BAR; PG8_SCHED;
            PG8_STAGE(PG8_SB(1, 1), b3 + hstep, voffB);
            PG8_WAIT_V(6); PG8_BAR; PG8_MMA(1, 1, At, B1); PG8_BAR;
            }
        }
        if constexpr (ALIGN_EPI) { if (wr == 0) PG8_BAR; }
        if constexpr (!Epi::AFTER_DRAIN) { const int le_ = olane(); E(acc, cur, wr, wc, le_ & 15, le_ >> 4); S.done(cur); }
        if (!has_next) break;
#pragma unroll
        for (int a = 0; a < 2; ++a)
#pragma unroll
            for (int b = 0; b < 2; ++b)
#pragma unroll
                for (int m = 0; m < 4; ++m)
#pragma unroll
                    for (int n = 0; n < 2; ++n) acc[a][b][m][n] = (f32x4){0.f, 0.f, 0.f, 0.f};
        cur = nxt; cA = nA; cB = nB; ++ui;
        if constexpr (ALIGN_EPI) { if (wr == 1) PG8_BAR; }
    }
    PG8_WAIT_V(0);
    if constexpr (!ALIGN_EPI) { if (wr == 0) PG8_BAR; }
    PG8_BAR;
    if constexpr (Epi::AFTER_DRAIN) { E.fused(acc, cur, wr, wc, fr, fq, lds, wid, lane); S.done(cur); }
#undef PG8_SA
#undef PG8_SB
#undef PG8_STAGE
#undef PG8_LDA
#undef PG8_LDB
#undef PG8_MMA
#undef PG8_WAIT_V
#undef PG8_WAIT_L
#undef PG8_BAR
#undef PG8_SCHED
}
}

#define GAS __attribute__((address_space(1)))
#define LAS __attribute__((address_space(3)))
typedef unsigned short bf16;
typedef unsigned v4u __attribute__((ext_vector_type(4)));
typedef unsigned v2u __attribute__((ext_vector_type(2)));
typedef float f32x4 __attribute__((ext_vector_type(4)));
#define LDS_WAIT() asm volatile("s_waitcnt lgkmcnt(0)" ::: "memory")
#define VM_WAIT() asm volatile("s_waitcnt vmcnt(0)" ::: "memory")
__device__ __forceinline__ unsigned f2bf(float f) { unsigned u = __builtin_bit_cast(unsigned, f); return (u + 0x7fffu + ((u >> 16) & 1u)) >> 16; }
typedef float f32x2q __attribute__((ext_vector_type(2)));
typedef __bf16 bf16x2q __attribute__((ext_vector_type(2)));
__device__ __forceinline__ unsigned pk2(float lo, float hi) { const f32x2q v = {lo, hi}; return __builtin_bit_cast(unsigned, __builtin_convertvector(v, bf16x2q)); }
__device__ __forceinline__ float bflo(unsigned w) { return __builtin_bit_cast(float, w << 16); }
__device__ __forceinline__ float bfhi(unsigned w) { return __builtin_bit_cast(float, w & 0xffff0000u); }
__device__ __forceinline__ float wave_sum(float v) { v += shx<1>(v); v += shx<2>(v); v += shx<4>(v); v += shx<8>(v); v += shx<16>(v); return sum32(v); }

constexpr int NB = 4, SEQ = 8192, DM = 1024, NTOK = NB * SEQ;
constexpr int NPROJ = 2048, WS5 = 512, NEXP = 32, NHEAD = 8;
constexpr int MAXRB = 544, MAXROWS = MAXRB * 256;
constexpr float RMS_EPS = 1e-6f;
constexpr float QSCALE = 4.0f * 0.17677669529663687f * 1.4426950408889634f;
constexpr float ATT_QK_INV = 16.160312445f;

constexpr size_t MiB = 1u << 20;
constexpr size_t WS_CTL = 0, CTL_ZERO_BYTES = 1 * MiB;
constexpr size_t WS_ABAR = 1 * MiB, WS_BBR = WS_ABAR + 65536, WS_BBI = WS_BBR + 262144, WS_SCAL = WS_BBI + 262144;
constexpr size_t WS_MODP = 2 * MiB;
constexpr size_t WS_TOPI = 4 * MiB, WS_GATE = WS_TOPI + 512 * 1024, WS_DEST = WS_GATE + 512 * 1024, WS_ROWTOK = WS_DEST + 512 * 1024, WS_ROWGATE = WS_ROWTOK + 640 * 1024;
constexpr size_t WS_CS = 3 * MiB + 512 * 1024;
constexpr size_t WS_MODF = 7 * MiB + 512 * 1024;
constexpr size_t WS_PARTS = 275 * MiB;
constexpr size_t WS_PARTX = 272 * MiB;
constexpr size_t WS_CNT = 7 * MiB, WS_BLKE = WS_CNT + 256 * 1024, WS_NRB = WS_BLKE + 64 * 1024, WS_RWT = WS_NRB + 64 * 1024;
constexpr size_t WS_W1T8 = 8 * MiB, WS_W2T8 = 72 * MiB, WS_H8 = 104 * MiB, WS_H = 200 * MiB;
constexpr size_t WS_WINT = 264 * MiB, WS_GLUT = 268 * MiB, WS_WOUTT = 269 * MiB, WS_PROJ = 272 * MiB, WS_YF = 400 * MiB, WS_YB = 464 * MiB;
constexpr size_t WS_MIXIN = 528 * MiB, WS_YSPRE = 592 * MiB, WS_ZG = 624 * MiB, WS_MIXO = 656 * MiB;
constexpr size_t WS_QG = 720 * MiB, WS_KG = 752 * MiB, WS_VTG = 784 * MiB, WS_UG = 816 * MiB;
constexpr size_t WS_XS8 = 264 * MiB, WS_ACT8 = 400 * MiB, WS_YS = 536 * MiB, WS_XMID = 848 * MiB, WS_END = 912 * MiB;
static_assert(WS_ROWGATE + MAXROWS * 4 <= WS_CNT && WS_ROWTOK + MAXROWS * 4 <= WS_ROWGATE, "routing tables");
static_assert(WS_XS8 + (size_t)MAXROWS * 1024 <= WS_ACT8 && WS_ACT8 + (size_t)MAXROWS * 1024 <= WS_YS && WS_YS + (size_t)MAXROWS * 1024 <= WS_END, "moe buffers");
constexpr float YSCALE = 16.0f;
constexpr float WSCALE = 32.0f;
constexpr int CW_BAR = 4096;

constexpr int RING_OFF = 0, RING_BYTES = 131072;
constexpr int LDSCTL_OFF = RING_BYTES, MISC_OFF = LDSCTL_OFF + 320;
constexpr int S5_URING_OFF = 147456;
constexpr int LDS_BYTES = 163840;

struct Params { const float* in[33]; float* out; unsigned char* ws; int ph_lo, ph_hi, li, pad; };

#define XB_TMO      128
#define XB_XCNT(j)  (256  + 64 * (j))
#define XB_XSUB(j)  (1280 + 64 * (j))
#define XB_XGEN(j)  (2304 + 64 * (j))
#define XB_TOP      3328
#define XB_TOPGEN   3392
#define XCD_BAR_WORDS 3456
#define XB_SPIN_CAP (1u << 18)

__device__ __forceinline__ unsigned xb_ld(unsigned* p)              { return __hip_atomic_load(p, __ATOMIC_RELAXED, __HIP_MEMORY_SCOPE_AGENT); }
__device__ __forceinline__ unsigned xb_add(unsigned* p, unsigned v) { return __hip_atomic_fetch_add(p, v, __ATOMIC_RELAXED, __HIP_MEMORY_SCOPE_AGENT); }
__device__ __forceinline__ unsigned xb_xcc_id() { return (unsigned)__builtin_amdgcn_s_getreg((3 << 11) | 20) & 0xFu; }
#define XB_SPIN(cond, bar) do { unsigned _sp = 0; while (cond) { __builtin_amdgcn_s_sleep(1); \
    if ((++_sp & 255u) == 0u) { if (xb_ld(&(bar)[XB_TMO])) break; if (_sp > XB_SPIN_CAP) { atomicAdd(&(bar)[XB_TMO], 1u); break; } } } } while (0)

struct XcdBarrier {
    unsigned* bar; unsigned x;
    volatile LAS unsigned* st;
};

__device__ __forceinline__ XcdBarrier xcd_barrier_post(const int wv_, unsigned* bar, volatile LAS unsigned* st) {
    XcdBarrier b; b.bar = bar; b.x = xb_xcc_id(); b.st = st;
    if (otid() == 0) (void)xb_add(&bar[XB_XCNT(b.x)], 1u);
    return b;
}
__device__ __forceinline__ void xcd_barrier_complete(unsigned* bar, unsigned x, unsigned& nloc, unsigned& nx) {
    const unsigned G = gridDim.x * gridDim.y * gridDim.z;
    unsigned sum, cnt, mine, sp = 0u;
    for (;;) {
        sum = 0u; cnt = 0u; mine = 0u;
#pragma unroll
        for (unsigned j = 0; j < 16; ++j) { const unsigned c = xb_ld(&bar[XB_XCNT(j)]); sum += c; cnt += (c > 0u) ? 1u : 0u; mine = (j == x) ? c : mine; }
        if (sum == G) break;
        __builtin_amdgcn_s_sleep(1);
        if ((++sp & 255u) == 0u) { if (xb_ld(&bar[XB_TMO])) break; if (sp > XB_SPIN_CAP) { atomicAdd(&bar[XB_TMO], 1u); break; } }
    }
    nloc = mine > 0u ? mine : 1u; nx = cnt > 0u ? cnt : 1u;
}

__device__ __forceinline__ void xcd_barrier(const int wv_, const XcdBarrier& b) {
    asm volatile("s_waitcnt vmcnt(0)" ::: "memory");
    __syncthreads();
    if (otid() == 0) {
        unsigned* bar = b.bar;
        __builtin_amdgcn_s_waitcnt(0);
        unsigned nloc = b.st[0], nx = b.st[1];
        if (nloc == 0u) { xcd_barrier_complete(bar, b.x, nloc, nx); b.st[0] = nloc; b.st[1] = nx; }
        const unsigned old = xb_add(&bar[XB_XSUB(b.x)], 1u);
        const unsigned gen = old / nloc;
        if (old + 1u == (gen + 1u) * nloc) {
            __builtin_amdgcn_fence(__ATOMIC_RELEASE, "agent");
            asm volatile("s_waitcnt vmcnt(0)" ::: "memory");
            const unsigned og = xb_add(&bar[XB_TOP], 1u);
            const unsigned tg = og / nx;
            if (og + 1u == (tg + 1u) * nx) xb_add(&bar[XB_TOPGEN], 1u);
            else XB_SPIN(xb_ld(&bar[XB_TOPGEN]) == tg, bar);
            __builtin_amdgcn_fence(__ATOMIC_ACQUIRE, "agent");
            asm volatile("s_waitcnt vmcnt(0)" ::: "memory");
        } else {
            XB_SPIN(xb_ld(&bar[XB_TOPGEN]) == gen, bar);
            __builtin_amdgcn_fence(__ATOMIC_ACQUIRE, "agent");
            asm volatile("s_waitcnt vmcnt(0)" ::: "memory");
        }
    }
    __syncthreads();
}

__device__ __forceinline__ float silu_f(float v) { return v / (1.0f + __expf(-v)); }
__device__ __forceinline__ float mod_val(const Params& p, int b, int idx) {
    const float* modp = (const float*)(p.ws + WS_MODP); float s = p.in[4][idx];
#pragma unroll
    for (int ks = 0; ks < 16; ++ks) s += modp[(size_t)(ks * 4 + b) * 6144 + idx];
    return s;
}

__device__ __forceinline__ void p0_transpose_item(const float* W, int K, int N, bf16* WT, LAS float* scr, int item, int lane) {
    const int nblk = N / 32, kb = item / nblk, nb = item % nblk, k0 = 64 * kb, n0 = 32 * nb;
#pragma unroll 8
    for (int i = 0; i < 32; ++i) { const int kk = 2 * i + (lane >> 5); scr[kk * 33 + (lane & 31)] = __builtin_nontemporal_load(W + (size_t)(k0 + kk) * N + n0 + (lane & 31)); }
    LDS_WAIT(); asm volatile("" ::: "memory");
    const int c = lane & 7;
#pragma unroll
    for (int j = 0; j < 4; ++j) { const int n = (lane >> 3) + 8 * j; const LAS float* s = scr + (8 * c) * 33 + n;
        v4u o; o.x = pk2(s[0 * 33], s[1 * 33]); o.y = pk2(s[2 * 33], s[3 * 33]); o.z = pk2(s[4 * 33], s[5 * 33]); o.w = pk2(s[6 * 33], s[7 * 33]);
        *(v4u*)(WT + (size_t)(n0 + n) * K + k0 + 8 * c) = o; }
    LDS_WAIT(); asm volatile("" ::: "memory");
}

__device__ __forceinline__ void p0_transpose_item8(const float* W, int K, int N, unsigned char* WT8, LAS float* scr, int item, int lane, float scale) {
    const int nblk = N / 32, kb = item / nblk, nb = item % nblk, k0 = 64 * kb, n0 = 32 * nb;
    float wv[32];
#pragma unroll
    for (int i = 0; i < 32; ++i) wv[i] = __builtin_nontemporal_load(W + (size_t)(k0 + 2 * i + (lane >> 5)) * N + n0 + (lane & 31));
#pragma unroll
    for (int i = 0; i < 32; ++i) scr[(2 * i + (lane >> 5)) * 33 + (lane & 31)] = wv[i];
    LDS_WAIT(); asm volatile("" ::: "memory");
    const int c = lane & 7;
#pragma unroll
    for (int j = 0; j < 4; ++j) { const int n = (lane >> 3) + 8 * j; const LAS float* s = scr + (8 * c) * 33 + n;
        v2u o; o.x = pg8::pk4_fp8(s[0 * 33] * scale, s[1 * 33] * scale, s[2 * 33] * scale, s[3 * 33] * scale); o.y = pg8::pk4_fp8(s[4 * 33] * scale, s[5 * 33] * scale, s[6 * 33] * scale, s[7 * 33] * scale);
        *(v2u*)(WT8 + (size_t)(n0 + n) * K + k0 + 8 * c) = o; }
    LDS_WAIT(); asm volatile("" ::: "memory");
}

__device__ __forceinline__ void p0_transpose_item_rot(const float* W, int K, int N, bf16* WT, LAS float* scr, int item, int lane, const float* rowscale) {
    const int nblk = N / 32, kb = item / nblk, nb = item % nblk, k0 = 64 * kb, n0 = 32 * nb;
#pragma unroll 8
    for (int i = 0; i < 32; ++i) { const int kk = 2 * i + (lane >> 5), kp = k0 + kk; const int ks = (kp + 512) & 1023; const float sc = kp < 512 ? rowscale[kp] : 1.0f;
        scr[kk * 33 + (lane & 31)] = W[(size_t)ks * N + n0 + (lane & 31)] * sc; }
    LDS_WAIT(); asm volatile("" ::: "memory");
    const int c = lane & 7;
#pragma unroll
    for (int j = 0; j < 4; ++j) { const int n = (lane >> 3) + 8 * j; const LAS float* s = scr + (8 * c) * 33 + n;
        v4u o; o.x = pk2(s[0 * 33], s[1 * 33]); o.y = pk2(s[2 * 33], s[3 * 33]); o.z = pk2(s[4 * 33], s[5 * 33]); o.w = pk2(s[6 * 33], s[7 * 33]);
        *(v4u*)(WT + (size_t)(n0 + n) * K + k0 + 8 * c) = o; }
    LDS_WAIT(); asm volatile("" ::: "memory");
}

__device__ __forceinline__ void ph_prologue(const int wv_, const Params& p, LAS unsigned char* lds) {
    const int tid = otid(), lane = tid & 63, wave = tid >> 6, G = gridDim.x, bid = blockIdx.x;
    const int gw = bid * 8 + wave, NGW = G * 8;
    unsigned char* ws = p.ws;
    {
        const float* c = p.in[1]; const float* aw = p.in[3]; float* modp = (float*)(ws + WS_MODP);
        for (int it = gw; it < 1536; it += NGW) { const int cg = it % 96, ks = it / 96, j = cg * 64 + lane;
            float a0 = 0.f, a1 = 0.f, a2 = 0.f, a3 = 0.f;
            const float s0 = silu_f(c[ks * 64 + lane]), s1 = silu_f(c[1024 + ks * 64 + lane]), s2 = silu_f(c[2048 + ks * 64 + lane]), s3 = silu_f(c[3072 + ks * 64 + lane]);
#pragma unroll
            for (int kk = 0; kk < 64; ++kk) { const int k = ks * 64 + kk; const float w = aw[(size_t)k * 6144 + j];
                a0 += __builtin_bit_cast(float, __builtin_amdgcn_readlane(__builtin_bit_cast(int, s0), kk)) * w; a1 += __builtin_bit_cast(float, __builtin_amdgcn_readlane(__builtin_bit_cast(int, s1), kk)) * w;
                a2 += __builtin_bit_cast(float, __builtin_amdgcn_readlane(__builtin_bit_cast(int, s2), kk)) * w; a3 += __builtin_bit_cast(float, __builtin_amdgcn_readlane(__builtin_bit_cast(int, s3), kk)) * w; }
            modp[(size_t)(ks * 4 + 0) * 6144 + j] = a0; modp[(size_t)(ks * 4 + 1) * 6144 + j] = a1; modp[(size_t)(ks * 4 + 2) * 6144 + j] = a2; modp[(size_t)(ks * 4 + 3) * 6144 + j] = a3; }
    }
    {
        LAS float* scr = (LAS float*)(lds + RING_OFF + wave * 16384);
        constexpr int I_IN = 16 * 64, I_GLU = 8 * 16, I_OUT = 16 * 32, I_RW = 16, I_1 = 8 * 64, I_2 = 8 * 32;
        constexpr int NITEMS = I_IN + I_GLU + I_OUT + I_RW;
        for (int it = gw; it < NITEMS; it += NGW) {
            int r = it;
            if (r < I_IN) { p0_transpose_item8(p.in[6], 1024, 2048, ws + WS_WINT, scr, r, lane, WSCALE); continue; } r -= I_IN;
            if (r < I_GLU) { p0_transpose_item(p.in[22], 512, 512, (bf16*)(ws + WS_GLUT), scr, r, lane); continue; } r -= I_GLU;
            if (r < I_OUT) { p0_transpose_item_rot(p.in[25], 1024, 1024, (bf16*)(ws + WS_WOUTT), scr, r, lane, p.in[24]); continue; } r -= I_OUT;
            if (r < I_RW) { p0_transpose_item(p.in[27], 1024, 32, (bf16*)(ws + WS_RWT), scr, r, lane); continue; } r -= I_RW;
        }
    }
    {
        const int gt = bid * 512 + tid;
        if (gt < 4096) {
            const int dg = gt >> 6;
            const float lr = p.in[14][gt], li = p.in[15][gt], delta = expf(p.in[16][dg]);
            const float mag = expf(lr * delta), ar = mag * cosf(li * delta), ai = mag * sinf(li * delta);
            const float den = lr * lr + li * li, nr = ar - 1.0f, fr = (nr * lr + ai * li) / den, fi = (ai * lr - nr * li) / den;
            float* abar = (float*)(ws + WS_ABAR); float* bbr = (float*)(ws + WS_BBR); float* bbi = (float*)(ws + WS_BBI);
            abar[gt * 2] = ar; abar[gt * 2 + 1] = ai;
            for (int c = 0; c < 16; ++c) { const float br = p.in[17][gt * 16 + c], bi = p.in[18][gt * 16 + c];
                bbr[gt * 16 + c] = fr * br - fi * bi; bbi[gt * 16 + c] = fr * bi + fi * br; }
        }
        if (gt == 0) { float s1 = 0.f, s2 = 0.f;
            for (int i = 0; i < 32; ++i) { s1 += p.in[9][i] * p.in[10][i]; s2 += p.in[11][i] * p.in[12][i]; }
            ((float*)(ws + WS_SCAL))[0] = expf(s1) - expf(s2) + 0.2f; }
    }
}

__device__ __forceinline__ void ph_norm1(const int wv_, const Params& p, LAS unsigned char* lds) {
    const int tid = otid(), lane = tid & 63, wave = tid >> 6;
    LAS float* gs = (LAS float*)lds; LAS float* sh = gs + 1024;
    const float* x = p.in[0]; bf16* H = (bf16*)(p.ws + WS_H);
    for (int idx = blockIdx.x * 512 + tid; idx < NB * 6144; idx += gridDim.x * 512) ((float*)(p.ws + WS_MODF))[idx] = mod_val(p, idx / 6144, idx % 6144);
    for (int chunk = blockIdx.x; chunk < NTOK / 128; chunk += gridDim.x) {
        const int b = chunk / (SEQ / 128);
        for (int j = tid; j < 1024; j += 512) { gs[j] = p.in[5][j] * (1.0f + mod_val(p, b, 1024 + j)); sh[j] = mod_val(p, b, j); }
        __syncthreads();
        f32x4 vn[4];
        { const f32x4* xr = (const f32x4*)(x + (size_t)(chunk * 128 + wave * 16) * DM) + lane;
#pragma unroll
          for (int j = 0; j < 4; ++j) vn[j] = xr[64 * j]; }
        for (int i = 0; i < 16; ++i) { const int row = chunk * 128 + wave * 16 + i;
            f32x4 v[4]; float ss = 0.f;
#pragma unroll
            for (int j = 0; j < 4; ++j) v[j] = vn[j];
            { const f32x4* xr = (const f32x4*)(x + (size_t)(row + (i < 15 ? 1 : 0)) * DM) + lane;
#pragma unroll
              for (int j = 0; j < 4; ++j) vn[j] = xr[64 * j]; }
#pragma unroll
            for (int j = 0; j < 4; ++j) ss += (v[j].x * v[j].x + v[j].y * v[j].y) + (v[j].z * v[j].z + v[j].w * v[j].w);
            if (lane < 4) { const float invf = lane == 0 ? 1.0f : (lane == 1 ? 0.037606030930863934f : (lane == 2 ? 0.0014142135623730951f : 5.3182958969449884e-05f));
                const float ang = (float)((const int*)p.in[2])[row] * invf; float* cs = (float*)(p.ws + WS_CS) + (size_t)row * 8; cs[lane] = cosf(ang); cs[4 + lane] = sinf(ang); }
            const float rstd = rsqrtf(wave_sum(ss) * (1.0f / DM) + RMS_EPS);
#pragma unroll
            for (int j = 0; j < 4; ++j) { const int c0 = 4 * lane + 256 * j; const f32x4 g4 = *(const LAS f32x4*)(gs + c0), s4 = *(const LAS f32x4*)(sh + c0);
                ((unsigned*)(p.ws + WS_H8) + (size_t)row * (DM / 4))[lane + 64 * j] = pg8::pk4_fp8(v[j].x * rstd * g4.x + s4.x, v[j].y * rstd * g4.y + s4.y, v[j].z * rstd * g4.z + s4.z, v[j].w * rstd * g4.w + s4.w); }
        }
        __syncthreads();
    }
}

__device__ __forceinline__ void ph_qkv_prep(const int wv_, const Params& p, LAS unsigned char* lds) {
    const bf16* PROJ = (const bf16*)(p.ws + WS_PROJ); const int* pos = (const int*)p.in[2];
    bf16* QG = (bf16*)(p.ws + WS_QG); bf16* KG = (bf16*)(p.ws + WS_KG); bf16* VTG = (bf16*)(p.ws + WS_VTG);
    const int gt = blockIdx.x * 512 + otid(), NT = gridDim.x * 512;
    for (int item = gt; item < NTOK * 32; item += NT) {
        const int tok = item >> 5, sub = item & 31, which = sub >> 4, hm = sub & 15;
        const v4u* ptr = (const v4u*)(PROJ + (size_t)tok * NPROJ + which * 512 + hm * 32);
        float v[32];
#pragma unroll
        for (int i = 0; i < 4; ++i) { const v4u w = ptr[i];
            v[8 * i + 0] = bflo(w.x); v[8 * i + 1] = bfhi(w.x); v[8 * i + 2] = bflo(w.y); v[8 * i + 3] = bfhi(w.y);
            v[8 * i + 4] = bflo(w.z); v[8 * i + 5] = bfhi(w.z); v[8 * i + 6] = bflo(w.w); v[8 * i + 7] = bfhi(w.w); }
        float ss = 0.f;
#pragma unroll
        for (int i = 0; i < 32; ++i) ss += v[i] * v[i];
        const float rstd = rsqrtf(ss * (1.0f / 32.0f) + RMS_EPS);
        const float* nw = which ? p.in[8] : p.in[7];
#pragma unroll
        for (int i = 0; i < 32; ++i) v[i] = v[i] * rstd * nw[i];
        const float fpos = (float)pos[tok];
        const float invf[4] = {1.0f, 0.037606030930863934f, 0.0014142135623730951f, 5.3182958969449884e-05f};
#pragma unroll
        for (int i = 0; i < 4; ++i) { const float ang = fpos * invf[i]; const float cs = cosf(ang), sn = sinf(ang);
            const float t1 = v[i], t2 = v[4 + i]; v[i] = t1 * cs - t2 * sn; v[4 + i] = t2 * cs + t1 * sn; }
        const float sc = which ? 1.0f : QSCALE;
        const int b = tok / SEQ, sq = tok % SEQ, hh = hm >> 1, mp = hm & 1;
        v4u* dst = (v4u*)((which ? KG : QG) + ((size_t)((b * NHEAD + hh) * SEQ + sq)) * 64 + mp * 32);
#pragma unroll
        for (int i = 0; i < 4; ++i) { v4u w;
            w.x = pk2(v[8 * i + 0] * sc, v[8 * i + 1] * sc); w.y = pk2(v[8 * i + 2] * sc, v[8 * i + 3] * sc);
            w.z = pk2(v[8 * i + 4] * sc, v[8 * i + 5] * sc); w.w = pk2(v[8 * i + 6] * sc, v[8 * i + 7] * sc); dst[i] = w; }
    }
    {
        bf16* UG = (bf16*)(p.ws + WS_UG);
        for (int item = gt; item < NTOK * 32; item += NT) { const int tok = item >> 5, g = item & 31, b = tok / SEQ, sq = tok % SEQ;
            const v4u* src = (const v4u*)(PROJ + (size_t)tok * NPROJ + 1536 + g * 16); v4u* dst = (v4u*)(UG + ((size_t)(b * 32 + g) * SEQ + sq) * 16);
            dst[0] = src[0]; dst[1] = src[1]; }
    }
    {
        const int lane = otid() & 63, wave = otid() >> 6;
        LAS unsigned short* T = (LAS unsigned short*)(lds + wave * 8448);
        for (int it = blockIdx.x * 8 + wave; it < NB * NHEAD * (SEQ / 64); it += gridDim.x * 8) {
            const int st = it % (SEQ / 64), h = (it / (SEQ / 64)) % NHEAD, b = it / ((SEQ / 64) * NHEAD);
            const v4u* src = (const v4u*)(PROJ + (size_t)(b * SEQ + st * 64 + lane) * NPROJ + 1024 + h * 64);
#pragma unroll
            for (int i = 0; i < 8; ++i) { const v4u w = src[i];
                T[(8 * i + 0) * 66 + lane] = (unsigned short)(w.x & 0xffffu); T[(8 * i + 1) * 66 + lane] = (unsigned short)(w.x >> 16);
                T[(8 * i + 2) * 66 + lane] = (unsigned short)(w.y & 0xffffu); T[(8 * i + 3) * 66 + lane] = (unsigned short)(w.y >> 16);
                T[(8 * i + 4) * 66 + lane] = (unsigned short)(w.z & 0xffffu); T[(8 * i + 5) * 66 + lane] = (unsigned short)(w.z >> 16);
                T[(8 * i + 6) * 66 + lane] = (unsigned short)(w.w & 0xffffu); T[(8 * i + 7) * 66 + lane] = (unsigned short)(w.w >> 16); }
            LDS_WAIT(); asm volatile("" ::: "memory");
            const LAS unsigned* row = (const LAS unsigned*)(T + lane * 66);
            v4u* dst = (v4u*)(VTG + ((size_t)((b * NHEAD + h) * 64 + lane)) * SEQ + st * 64);
#pragma unroll
            for (int i = 0; i < 8; ++i) { v4u w; w.x = row[4 * i]; w.y = row[4 * i + 1]; w.z = row[4 * i + 2]; w.w = row[4 * i + 3]; dst[i] = w; }
            LDS_WAIT(); asm volatile("" ::: "memory");
        }
    }
}

typedef short bf16x8 __attribute__((ext_vector_type(8)));
typedef float f32x16 __attribute__((ext_vector_type(16)));
__device__ __forceinline__ unsigned cvtpk(float lo, float hi) { unsigned r; asm("v_cvt_pk_bf16_f32 %0, %1, %2" : "=v"(r) : "v"(lo), "v"(hi)); return r; }
constexpr int ATT_NST = 4, ATT_STAGE = 32768, ATT_NT = SEQ / 128;
typedef float f32x2p __attribute__((ext_vector_type(2)));
typedef __bf16 bf16x2n __attribute__((ext_vector_type(2)));
__device__ __forceinline__ unsigned cvtpk2(float lo, float hi) { const f32x2p v = {lo, hi}; return __builtin_bit_cast(unsigned, __builtin_convertvector(v, bf16x2n)); }
typedef int i32x8a __attribute__((ext_vector_type(8)));
typedef int i32x4a __attribute__((ext_vector_type(4)));
typedef _Float16 f16x2a __attribute__((ext_vector_type(2)));
__device__ __forceinline__ int att_pk4b(float a, float b, float c, float d) {
    const unsigned h01 = __builtin_bit_cast(unsigned, __builtin_amdgcn_cvt_pkrtz(a, b)), h23 = __builtin_bit_cast(unsigned, __builtin_amdgcn_cvt_pkrtz(c, d));
    return (int)__builtin_amdgcn_perm(h23, h01, 0x07050301u); }
constexpr int ATT_MAGIC = (60 << 8) + 128;
__device__ __forceinline__ int att_pk4c(int a, int b, int c, int d) {
    const unsigned lo = __builtin_amdgcn_perm((unsigned)b, (unsigned)a, 0x0c0c0501u), hi = __builtin_amdgcn_perm((unsigned)d, (unsigned)c, 0x0c0c0501u);
    return (int)((hi << 16) | lo); }
typedef float f32x4l __attribute__((ext_vector_type(4)));
typedef int i32x16a __attribute__((ext_vector_type(16)));
struct AttRegs { i32x16a S[2][2]; i32x8a P8; i32x4a kf[2]; i32x8a vf8[2]; f32x4l La[2]; i32x8a ones; i32x16a CM; };
#define ATT_SB() do { } while (0)
#ifdef ATT_USE_PRIO
#define ATT_PRIO(x) __builtin_amdgcn_s_setprio(x)
#else
#define ATT_PRIO(x) do { } while (0)
#endif
template <int ST, int I>
__device__ __forceinline__ void att_item(LAS unsigned char* lds, const unsigned koff0, const unsigned voff0, const i32x4a (&qf)[2], f32x16 (&O)[2][2], AttRegs& R) {
    constexpr int m = I & 1, pm = m ^ 1;
    constexpr int J = I + 2, JST = (J >= 4) ? ((ST + 1) & 3) : ST, JG = (J & 3) >> 1, JM = J & 1;
#define CV(b, j) att_pk4c(R.S[m][b][j], R.S[m][b][j + 1], R.S[m][b][j + 2], R.S[m][b][j + 3])
    ATT_PRIO(1); O[pm][0] = __builtin_amdgcn_mfma_scale_f32_32x32x64_f8f6f4(R.vf8[0], R.P8, O[pm][0], 0, 1, 0, 0, 0, 0); ATT_PRIO(0);
    ATT_SB();
    ATT_PRIO(1); O[pm][1] = __builtin_amdgcn_mfma_scale_f32_32x32x64_f8f6f4(R.vf8[1], R.P8, O[pm][1], 0, 1, 0, 0, 0, 0); ATT_PRIO(0);
    R.La[pm] = __builtin_amdgcn_mfma_scale_f32_16x16x128_f8f6f4(R.ones, R.P8, R.La[pm], 4, 1, 0, 0x7f7f7f7f, 0, 0x7f7f7f7f);
    if (m == 0) {
#pragma unroll
        for (int mt = 0; mt < 2; ++mt) {
            const i32x4a lo = *(const LAS i32x4a*)(lds + (voff0 ^ (unsigned)(((I >> 1) * 4 + 0) << 4)) + ST * ATT_STAGE + 16384 + mt * 4096);
            const i32x4a hi = *(const LAS i32x4a*)(lds + (voff0 ^ (unsigned)(((I >> 1) * 4 + 1) << 4)) + ST * ATT_STAGE + 16384 + mt * 4096);
            R.vf8[mt] = __builtin_shufflevector(lo, hi, 0, 1, 2, 3, 4, 5, 6, 7); } }
    ATT_SB();
    ATT_PRIO(1); R.S[pm][0] = __builtin_amdgcn_mfma_i32_32x32x32_i8(R.kf[0], qf[pm], R.CM, 0, 0, 0); ATT_PRIO(0);
    R.P8[0] = CV(0, 0); R.P8[1] = CV(0, 4); R.P8[2] = CV(0, 8); R.P8[3] = CV(0, 12); ATT_SB();
    ATT_PRIO(1); R.S[pm][1] = __builtin_amdgcn_mfma_i32_32x32x32_i8(R.kf[1], qf[pm], R.CM, 0, 0, 0); ATT_PRIO(0);
#pragma unroll
    for (int b_ = 0; b_ < 2; ++b_) R.kf[b_] = *(const LAS i32x4a*)(lds + (koff0 ^ (unsigned)(JM << 5)) + JST * ATT_STAGE + JG * 4096 + b_ * 1024);
    R.P8[4] = CV(1, 0); R.P8[5] = CV(1, 4); R.P8[6] = CV(1, 8); R.P8[7] = CV(1, 12); ATT_SB();
#undef CV
}
__device__ __forceinline__ void ph_attn(const int wv_, const Params& p, LAS unsigned char* lds, const int i_lo, const int i_hi) {
    const unsigned char* QG = p.ws + WS_QG; const unsigned char* KG = p.ws + WS_KG; const unsigned char* VTG8 = p.ws + WS_VTG; bf16* MIXIN = (bf16*)(p.ws + WS_MIXIN);
#define ATT_DMA(st) do { \
        __builtin_amdgcn_global_load_lds((const unsigned*)kptr, (LAS unsigned*)(lds + (st) * ATT_STAGE + ldsw), 16, 0, 0); \
        __builtin_amdgcn_global_load_lds((const unsigned*)vptr, (LAS unsigned*)(lds + (st) * ATT_STAGE + 16384 + ldsw), 16, 0, 0); kptr += 8192; vptr += 128; } while (0)
#define ATT_TILE(ST) do { \
        att_item<ST, 0>(lds, koff0, voff0, qf, O, R); att_item<ST, 1>(lds, koff0, voff0, qf, O, R); \
        asm volatile("s_waitcnt vmcnt(2)" ::: "memory"); __builtin_amdgcn_s_barrier(); asm volatile("" ::: "memory"); \
        ATT_DMA(((ST) + 3) & 3); ATT_SB(); \
        att_item<ST, 2>(lds, koff0, voff0, qf, O, R); att_item<ST, 3>(lds, koff0, voff0, qf, O, R); } while (0)
    for (int i = i_lo; i < i_hi; ++i) {
        const int L = i * gridDim.x + blockIdx.x; if (L >= NB * NHEAD * (SEQ / 256)) break;
        const int bh = (L >> 8) * 8 + (L & 7), qb = (L >> 3) & 31;
        f32x16 O[2][2]; float lsum0, lsum1;
        {
            int tidu = otid(); asm volatile("" : "+v"(tidu));
            const int lane = tidu & 63, wave = __builtin_amdgcn_readfirstlane(tidu >> 6), r = lane & 31, h2 = lane >> 5;
            const int krow = tidu >> 3, kch = (tidu & 7) ^ ((krow >> 1) & 7);
            const int k8row = tidu >> 2, k8ch = (tidu & 3) ^ ((k8row >> 2) & 3);
            const char* kptr = (const char*)(KG + (size_t)bh * SEQ * 64) + (unsigned)(k8row * 64 + k8ch * 16);
            const char* vptr = (const char*)(VTG8 + (size_t)bh * 64 * SEQ) + (unsigned)(krow * SEQ + kch * 16);
            const int kap = 32 * ((r >> 2) & 1) + 4 * (r >> 3) + (r & 3);
            const unsigned koff0 = (unsigned)(kap * 64 + ((h2 ^ ((kap >> 2) & 3)) << 4));
            const unsigned voff0 = (unsigned)(r * 128 + (((2 * h2) ^ ((r >> 1) & 7)) << 4));
            const unsigned ldsw = (unsigned)wave * 1024u;
            i32x4a qf[2];
            { const unsigned char* qp = QG + ((size_t)bh * SEQ + qb * 256 + wave * 32 + r) * 64 + h2 * 16;
#pragma unroll
              for (int m = 0; m < 2; ++m) qf[m] = *(const i32x4a*)(qp + m * 32); }
            AttRegs R; R.P8 = (i32x8a){0, 0, 0, 0, 0, 0, 0, 0};
#pragma unroll
            for (int j = 0; j < 4; ++j) { R.La[0][j] = 0.f; R.La[1][j] = 0.f; }
            { const int lo_ = ((lane & 15) < 8) ? 0x22222222 : 0, hi_ = ((lane & 15) < 8) ? 0 : 0x22222222; R.ones = (i32x8a){lo_, lo_, hi_, hi_, 0, 0, 0, 0}; }
            { int mg_ = ATT_MAGIC; asm volatile("" : "+v"(mg_));
#pragma unroll
              for (int j = 0; j < 16; ++j) R.CM[j] = mg_;
              asm volatile("" : "+v"(R.CM)); }
#pragma unroll
            for (int m = 0; m < 2; ++m) {
#pragma unroll
                for (int mt = 0; mt < 2; ++mt)
#pragma unroll
                    for (int j = 0; j < 16; ++j) O[m][mt][j] = 0.f;
                R.vf8[m] = (i32x8a){0, 0, 0, 0, 0, 0, 0, 0};
            }
            ATT_DMA(0); ATT_DMA(1); ATT_DMA(2);
            asm volatile("s_waitcnt vmcnt(4)" ::: "memory"); __builtin_amdgcn_s_barrier(); asm volatile("" ::: "memory");
#pragma unroll
            for (int b_ = 0; b_ < 2; ++b_) R.kf[b_] = *(const LAS i32x4a*)(lds + koff0 + b_ * 1024);
#pragma unroll
            for (int b_ = 0; b_ < 2; ++b_) R.S[0][b_] = __builtin_amdgcn_mfma_i32_32x32x32_i8(R.kf[b_], qf[0], R.CM, 0, 0, 0);
            ATT_SB();
#pragma unroll
            for (int b_ = 0; b_ < 2; ++b_) R.kf[b_] = *(const LAS i32x4a*)(lds + (koff0 ^ 32u) + b_ * 1024);
            ATT_SB();
            for (int t = 0; t < ATT_NT; t += 4) { ATT_TILE(0); ATT_TILE(1); ATT_TILE(2); ATT_TILE(3); }
            O[1][0] = __builtin_amdgcn_mfma_scale_f32_32x32x64_f8f6f4(R.vf8[0], R.P8, O[1][0], 0, 1, 0, 0, 0, 0);
            O[1][1] = __builtin_amdgcn_mfma_scale_f32_32x32x64_f8f6f4(R.vf8[1], R.P8, O[1][1], 0, 1, 0, 0, 0, 0);
            { const int ld_ = otid() & 63; int lo1_ = ((ld_ & 15) < 8) ? 0x22222222 : 0, hi1_ = ((ld_ & 15) < 8) ? 0 : 0x22222222; asm volatile("" : "+v"(lo1_), "+v"(hi1_)); const i32x8a onesd = {lo1_, lo1_, hi1_, hi1_, 0, 0, 0, 0};
              R.La[1] = __builtin_amdgcn_mfma_scale_f32_16x16x128_f8f6f4(onesd, R.P8, R.La[1], 4, 1, 0, 0x7f7f7f7f, 0, 0x7f7f7f7f);
              const int r_ = ld_ & 31, src_ = (r_ < 16 ? r_ : r_ + 16) << 2;
              lsum0 = __builtin_bit_cast(float, __builtin_amdgcn_ds_bpermute(src_, __builtin_bit_cast(int, R.La[0][0]))); lsum1 = __builtin_bit_cast(float, __builtin_amdgcn_ds_bpermute(src_, __builtin_bit_cast(int, R.La[1][0]))); }
            asm volatile("s_waitcnt vmcnt(0)" ::: "memory"); __builtin_amdgcn_s_barrier(); asm volatile("" ::: "memory");
        }
        int tide = otid(); asm volatile("" : "+v"(tide));
        const int r = tide & 31, h2 = (tide >> 5) & 1, wave = tide >> 6;
        const float lam = ((const float*)(p.ws + WS_SCAL))[0];
        const float r0 = 1.0f / lsum0, r1 = lam / lsum1; float ss = 0.f;
#pragma unroll
        for (int mt = 0; mt < 2; ++mt)
#pragma unroll
            for (int j = 0; j < 16; ++j) { const float o = O[0][mt][j] * r0 - O[1][mt][j] * r1; O[0][mt][j] = o; ss += o * o; }
        ss = sum32(ss);
        const float rstd = rsqrtf(ss * (1.0f / 64.0f) + RMS_EPS) * 0.8f;
        const int b = bh >> 3, hh = bh & 7, q = qb * 256 + wave * 32 + r;
        bf16* orow = MIXIN + (size_t)(b * SEQ + q) * DM + 512 + hh * 64;
#pragma unroll
        for (int mt = 0; mt < 2; ++mt)
#pragma unroll
            for (int a = 0; a < 4; ++a) { const int dv0 = 32 * mt + 8 * a + 4 * h2; const f32x4 sw = *(const f32x4*)(p.in[13] + dv0);
                v2u w; w.x = pk2(O[0][mt][4 * a + 0] * rstd * sw.x, O[0][mt][4 * a + 1] * rstd * sw.y); w.y = pk2(O[0][mt][4 * a + 2] * rstd * sw.z, O[0][mt][4 * a + 3] * rstd * sw.w);
                *(v2u*)(orow + dv0) = w; }
    }
#undef ATT_DMA
#undef ATT_TILE
}

typedef float f32x4m __attribute__((ext_vector_type(4)));
constexpr int CV_PAIRS = NEXP * (8 * 64 + 8 * 32);
struct CvCtx { int gw, ngw, nslots, slot, pend; unsigned char* dst; LAS float* scr; };
__device__ __forceinline__ void cv_issue(const Params& p, CvCtx& cv, int lane) {
    const int pair = (cv.slot >> 1) * cv.ngw + cv.gw, hk = cv.slot & 1; ++cv.slot;
    if (pair >= CV_PAIRS) return;
    const bool m1 = pair < NEXP * 512;
    int lgN, k0, n0; unsigned so;
    if (m1) { const int e = pair >> 9, q = pair & 511; cv.dst = p.ws + WS_W1T8 + (size_t)e * 2048 * 1024; lgN = 11; k0 = 64 * (2 * (q >> 6) + hk); n0 = 32 * (q & 63); so = (unsigned)e * (1024u * 2048u * 4u); }
    else { const int r = pair - NEXP * 512, e = r >> 8, q = r & 255; cv.dst = p.ws + WS_W2T8 + (size_t)e * 1024 * 1024; lgN = 10; k0 = 64 * (2 * (q >> 5) + hk); n0 = 32 * (q & 31); so = (unsigned)e * (1024u * 1024u * 4u); }
    cv.dst += (size_t)n0 * 1024 + k0;
    so += ((unsigned)k0 << (lgN + 2)) + (unsigned)n0 * 4u;
    const __amdgpu_buffer_rsrc_t rs = __builtin_amdgcn_make_buffer_rsrc((void*)(m1 ? p.in[29] : p.in[31]), 0, 0x7fffffff, 0x00020000);
    const unsigned vrow = (unsigned)(lane >> 3) << (lgN + 2), l7 = (unsigned)(lane & 7) << 4;
#pragma unroll
    for (int i = 0; i < 8; ++i)
        __builtin_amdgcn_raw_ptr_buffer_load_lds(rs, (LAS void*)((LAS char*)cv.scr + i * 1024), 16, (int)(vrow + (l7 ^ (unsigned)(i << 4))), (int)(so + ((unsigned)(8 * i) << (lgN + 2))), 0, 2);
    cv.pend = 1;
}
template <int VMC>
__device__ __forceinline__ void cv_finish(CvCtx& cv, int lane) {
    asm volatile("s_waitcnt vmcnt(%0)" :: "n"(VMC) : "memory");
    const int c = lane & 7;
#pragma unroll 1
    for (int j = 0; j < 4; ++j) { const int n = (lane >> 3) + 8 * j; float sv[8];
        const LAS float* q0 = cv.scr + (8 * c) * 32 + (((n >> 2) ^ c) << 2) + (n & 3);
#pragma unroll
        for (int q = 0; q < 8; ++q) sv[q] = q0[q * 32];
        asm volatile("" : "+v"(sv[0]), "+v"(sv[1]), "+v"(sv[2]), "+v"(sv[3]), "+v"(sv[4]), "+v"(sv[5]), "+v"(sv[6]), "+v"(sv[7]));
#pragma unroll
        for (int q = 0; q < 8; ++q) sv[q] *= WSCALE;
        v2u o; o.x = pg8::pk4_fp8(sv[0], sv[1], sv[2], sv[3]); o.y = pg8::pk4_fp8(sv[4], sv[5], sv[6], sv[7]);
        *(v2u*)(cv.dst + (size_t)n * 1024 + 8 * c) = o; }
    LDS_WAIT(); asm volatile("" ::: "memory");
    cv.pend = 0;
}
template <bool OUT>
__device__ __forceinline__ void s5_pass(LAS unsigned char* xt, const __amdgpu_buffer_rsrc_t urs, const unsigned ubyte0, LAS unsigned char* uring, bf16* Yb, int di, int lane, int wave, const bf16x8 (&bfr)[4], const bf16x8 (&cfr)[4],
                                        const float (&ar)[2], const float (&ai)[2], float (&xr)[2], float (&xi)[2], const Params& p, CvCtx& cv) {
    const int n = lane & 31, h = lane >> 5;
    const int m = lane & 31, hh = (m >> 2) & 1, tokin = 4 * (m >> 3) + (m & 3);
    const int ubase_tok = (2 * wave + hh) * 512 + tokin;
#define S5_UDMA(tn_, slot_) do { const int tp_ = ubase_tok + 16 * (tn_); \
        __builtin_amdgcn_raw_ptr_buffer_load_lds(urs, (LAS void*)(uring + (slot_) * 1024), 16, (int)(ubyte0 + (unsigned)(di ? (SEQ - 1 - tp_) : tp_) * 32u), 0, 0, 0); } while (0)
    S5_UDMA(0, 0); S5_UDMA(1, 1);
    asm volatile("s_waitcnt vmcnt(1)" ::: "memory");
    for (int t = 0; t < 32; ++t) {
        asm volatile("s_waitcnt vmcnt(%0)" :: "n"(OUT ? 3 : 1) : "memory");
        const bf16x8 uf = *(const LAS bf16x8*)(uring + (t & 1) * 1024 + lane * 16);
        LDS_WAIT(); asm volatile("" ::: "memory");
        if (cv.pend) cv_finish<OUT ? 3 : 1>(cv, lane);
        else if ((0x29 >> (t & 7)) & 1) { if (cv.slot < cv.nslots) cv_issue(p, cv, lane); }
        asm volatile("" ::: "memory");
        S5_UDMA((t + 2 < 32) ? t + 2 : 31, t & 1);
        asm volatile("" ::: "memory");
        f32x16 acc[4];
#pragma unroll
        for (int j = 0; j < 4; ++j) { f32x16 z = {0.f, 0.f, 0.f, 0.f, 0.f, 0.f, 0.f, 0.f, 0.f, 0.f, 0.f, 0.f, 0.f, 0.f, 0.f, 0.f}; acc[j] = __builtin_amdgcn_mfma_f32_32x32x16_bf16(uf, bfr[j], z, 0, 0, 0); }
#pragma unroll
        for (int i = 0; i < 16; ++i)
#pragma unroll
            for (int s = 0; s < 2; ++s) {
                const float nr = fmaf(ar[s], xr[s], fmaf(-ai[s], xi[s], acc[2 * s][i]));
                const float ni = fmaf(ar[s], xi[s], fmaf(ai[s], xr[s], acc[2 * s + 1][i]));
                xr[s] = nr; xi[s] = ni; acc[2 * s][i] = nr; acc[2 * s + 1][i] = ni; }
        if (OUT) {
#pragma unroll
            for (int i = 0; i < 16; ++i)
#pragma unroll
                for (int s = 0; s < 2; ++s) { const int c = (n >> 2) + 8 * s;
                    *(LAS unsigned*)(xt + h * 4096 + i * 256 + ((c ^ i) * 16) + (n & 3) * 4) = cvtpk(acc[2 * s][i], acc[2 * s + 1][i]); }
            const int row = lane & 15, kq = lane >> 4;
#pragma unroll
            for (int h2 = 0; h2 < 2; ++h2) { f32x4m y = {0.f, 0.f, 0.f, 0.f};
#pragma unroll
                for (int ks = 0; ks < 4; ++ks) { const bf16x8 af = *(const LAS bf16x8*)(xt + h2 * 4096 + row * 256 + (((ks * 4 + kq) ^ row) * 16));
                    y = __builtin_amdgcn_mfma_f32_16x16x32_bf16(af, cfr[ks], y, 0, 0, 0); }
                { const int tok0 = (2 * wave + h2) * 512 + 16 * t + 4 * kq; v2u w; int pos4;
                  if (!di) { pos4 = tok0 >> 2; w.x = cvtpk2(y[0], y[1]); w.y = cvtpk2(y[2], y[3]); } else { pos4 = (SEQ - 1 - tok0) >> 2; w.x = cvtpk2(y[3], y[2]); w.y = cvtpk2(y[1], y[0]); }
                  *(v2u*)(Yb + (size_t)pos4 * 64 + row * 4) = w; }
            }
        }
    }
#undef S5_UDMA
}
__device__ __forceinline__ void ph_s5(const int wv_, const Params& p, LAS unsigned char* lds) {
    const int tid = otid(), lane = tid & 63, wave = __builtin_amdgcn_readfirstlane(tid >> 6), n = lane & 31, h = lane >> 5;
    const bf16* UG = (const bf16*)(p.ws + WS_UG);
    const float* abar = (const float*)(p.ws + WS_ABAR); const float* bbr = (const float*)(p.ws + WS_BBR); const float* bbi = (const float*)(p.ws + WS_BBI);
    LAS unsigned char* xt = lds + wave * 8192; LAS float* Es = (LAS float*)(lds + 65536);
    CvCtx cv; cv.gw = blockIdx.x * 8 + wave; cv.ngw = gridDim.x * 8; cv.nslots = 2 * ((CV_PAIRS + cv.ngw - 1) / cv.ngw); cv.slot = 0; cv.pend = 0; cv.dst = p.ws;
    const __amdgpu_buffer_rsrc_t urs = __builtin_amdgcn_make_buffer_rsrc((void*)UG, 0, 0x7fffffff, 0x00020000);
    LAS unsigned char* uring = lds + S5_URING_OFF + wave * 2048;
    cv.scr = (LAS float*)(wave < 7 ? lds + 73728 + wave * 8192 : lds + LDSCTL_OFF + 4096);
    for (int u = blockIdx.x; u < NB * 32 * 2; u += gridDim.x) {
        const int di = u & 1, g = (u >> 1) & 31, b = u >> 6, dg = di * 32 + g;
        float ar[2], ai[2], a5r[2], a5i[2];
#pragma unroll
        for (int s = 0; s < 2; ++s) { const int sp = dg * 64 + n + 32 * s; ar[s] = abar[sp * 2]; ai[s] = abar[sp * 2 + 1];
            float pr = ar[s], pi = ai[s];
#pragma unroll
            for (int k = 0; k < 9; ++k) { const float nr = pr * pr - pi * pi, ni = 2.0f * pr * pi; pr = nr; pi = ni; }
            a5r[s] = pr; a5i[s] = pi; }
        bf16x8 bfr[4], cfr[4];
#pragma unroll
        for (int j = 0; j < 4; ++j) { const float* src = ((j & 1) ? bbi : bbr) + (size_t)(dg * 64 + n + 32 * (j >> 1)) * 16 + 8 * h;
            const f32x4 v0 = *(const f32x4*)src, v1 = *(const f32x4*)(src + 4);
            v4u w = {pk2(v0.x, v0.y), pk2(v0.z, v0.w), pk2(v1.x, v1.y), pk2(v1.z, v1.w)}; bfr[j] = __builtin_bit_cast(bf16x8, w); }
        { const int ch = lane & 15, kq = lane >> 4; const float* cre = p.in[19] + (size_t)(dg * 16 + ch) * 64; const float* cim = p.in[20] + (size_t)(dg * 16 + ch) * 64;
#pragma unroll
          for (int ks = 0; ks < 4; ++ks) { const int p0 = 16 * ks + 4 * kq; const f32x4 r4 = *(const f32x4*)(cre + p0), i4 = *(const f32x4*)(cim + p0);
              v4u w = {pk2(r4.x, -i4.x), pk2(r4.y, -i4.y), pk2(r4.z, -i4.z), pk2(r4.w, -i4.w)}; cfr[ks] = __builtin_bit_cast(bf16x8, w); } }
        const unsigned ubyte0 = (unsigned)(b * 32 + g) * (SEQ * 32u) + 16u * h;
        bf16* Yb = (bf16*)(p.ws + WS_YF) + ((size_t)((di * NB + b) * 32 + g)) * (SEQ / 4) * 64;
        float z0_ = 0.f; asm volatile("" : "+v"(z0_));
        float xr[2] = {z0_, z0_}, xi[2] = {z0_, z0_};
        s5_pass<false>(xt, urs, ubyte0, uring, Yb, di, lane, wave, bfr, cfr, ar, ai, xr, xi, p, cv);
        if (cv.pend) cv_finish<0>(cv, lane);
        const int sg = 2 * wave + h;
#pragma unroll
        for (int s = 0; s < 2; ++s) { Es[(sg * 64 + n + 32 * s) * 2] = xr[s]; Es[(sg * 64 + n + 32 * s) * 2 + 1] = xi[s]; }
        __syncthreads();
        float cr[2] = {z0_, z0_}, ci[2] = {z0_, z0_};
        for (int j = 0; j < 15; ++j) {
#pragma unroll
            for (int s = 0; s < 2; ++s) { const float er = Es[(j * 64 + n + 32 * s) * 2], ei = Es[(j * 64 + n + 32 * s) * 2 + 1];
                const float nr = a5r[s] * cr[s] - a5i[s] * ci[s] + er, ni = a5r[s] * ci[s] + a5i[s] * cr[s] + ei;
                cr[s] = (j < sg) ? nr : cr[s]; ci[s] = (j < sg) ? ni : ci[s]; } }
        __syncthreads();
        xr[0] = cr[0]; xr[1] = cr[1]; xi[0] = ci[0]; xi[1] = ci[1];
        s5_pass<true>(xt, urs, ubyte0, uring, Yb, di, lane, wave, bfr, cfr, ar, ai, xr, xi, p, cv);
        if (cv.pend) cv_finish<0>(cv, lane);
    }
    while (cv.slot < cv.nslots) { cv_issue(p, cv, lane); if (cv.pend) cv_finish<0>(cv, lane); }
}

__device__ __forceinline__ float gelu_tanh(float y) {
    const float z = 0.7978845608028654f * (y + 0.044715f * y * y * y);
    const float th = 1.0f - 2.0f * __builtin_amdgcn_rcpf(1.0f + __expf(2.0f * z));
    return 0.5f * y * (1.0f + th);
}
__device__ __forceinline__ void ph_s5_gelu(const int wv_, const Params& p) {
    const bf16* UG = (const bf16*)(p.ws + WS_UG); const bf16* YG = (const bf16*)(p.ws + WS_YF); bf16* YSPRE = (bf16*)(p.ws + WS_YSPRE);
    const int gt = blockIdx.x * 512 + otid(), NT = gridDim.x * 512;
    for (int it = gt; it < NB * 32 * (SEQ / 4) * 4; it += NT) {
        const int q = it & 3, g = (it >> 2) & 31, pos4 = (it >> 7) & (SEQ / 4 - 1), b = it >> 18;
        const size_t yo = ((size_t)(b * 32 + g) * (SEQ / 4) + pos4) * 64 + q * 16;
        const v4u f0 = __builtin_nontemporal_load((const v4u*)(YG + yo)), f1 = __builtin_nontemporal_load((const v4u*)(YG + yo + 8));
        const v4u r0 = __builtin_nontemporal_load((const v4u*)(YG + (size_t)NB * 32 * (SEQ / 4) * 64 + yo)), r1 = __builtin_nontemporal_load((const v4u*)(YG + (size_t)NB * 32 * (SEQ / 4) * 64 + yo + 8));
        const f32x4 d4 = *(const f32x4*)(p.in[21] + g * 16 + 4 * q);
        const unsigned fw[8] = {f0.x, f0.y, f0.z, f0.w, f1.x, f1.y, f1.z, f1.w}, rw[8] = {r0.x, r0.y, r0.z, r0.w, r1.x, r1.y, r1.z, r1.w};
        float yv[4][4];
#pragma unroll
        for (int cc = 0; cc < 4; ++cc) { yv[cc][0] = bflo(fw[2 * cc]) + bflo(rw[2 * cc]); yv[cc][1] = bfhi(fw[2 * cc]) + bfhi(rw[2 * cc]);
            yv[cc][2] = bflo(fw[2 * cc + 1]) + bflo(rw[2 * cc + 1]); yv[cc][3] = bfhi(fw[2 * cc + 1]) + bfhi(rw[2 * cc + 1]); }
#pragma unroll
        for (int t4 = 0; t4 < 4; ++t4) { const int sq = 4 * pos4 + t4;
            const v2u uw = *(const v2u*)(UG + ((size_t)(b * 32 + g) * SEQ + sq) * 16 + 4 * q);
            const float y0 = d4.x * bflo(uw.x) + yv[0][t4], y1 = d4.y * bfhi(uw.x) + yv[1][t4], y2 = d4.z * bflo(uw.y) + yv[2][t4], y3 = d4.w * bfhi(uw.y) + yv[3][t4];
            v2u o; o.x = pk2(gelu_tanh(y0), gelu_tanh(y1)); o.y = pk2(gelu_tanh(y2), gelu_tanh(y3));
            *(v2u*)(YSPRE + (size_t)(b * SEQ + sq) * WS5 + g * 16 + 4 * q) = o; }
    }
}
__device__ __forceinline__ void ph_s5_gate(const int wv_, const Params& p) {
    const bf16* YSPRE = (const bf16*)(p.ws + WS_YSPRE); const bf16* ZG = (const bf16*)(p.ws + WS_ZG); bf16* MIXIN = (bf16*)(p.ws + WS_MIXIN);
    const int lane = otid() & 63, gw = blockIdx.x * 8 + (otid() >> 6), NGW = gridDim.x * 8;
    const f32x4 w0 = *(const f32x4*)(p.in[24] + lane * 8), w1 = *(const f32x4*)(p.in[24] + lane * 8 + 4);
    for (int row = gw; row < NTOK; row += NGW) {
        const v4u yw = __builtin_nontemporal_load((const v4u*)(YSPRE + (size_t)row * WS5 + lane * 8)), zw = __builtin_nontemporal_load((const v4u*)(ZG + (size_t)row * WS5 + lane * 8));
        const float y[8] = {bflo(yw.x), bfhi(yw.x), bflo(yw.y), bfhi(yw.y), bflo(yw.z), bfhi(yw.z), bflo(yw.w), bfhi(yw.w)};
        const float z[8] = {bflo(zw.x), bfhi(zw.x), bflo(zw.y), bfhi(zw.y), bflo(zw.z), bfhi(zw.z), bflo(zw.w), bfhi(zw.w)};
        float s[8]; float ss = 0.f;
#pragma unroll
        for (int i = 0; i < 8; ++i) { s[i] = y[i] * __builtin_amdgcn_rcpf(1.0f + __expf(-z[i])); ss += s[i] * s[i]; }
        const float rstd = rsqrtf(wave_sum(ss) * (1.0f / WS5) + RMS_EPS);
        v4u o; o.x = pk2(s[0] * rstd * w0.x, s[1] * rstd * w0.y); o.y = pk2(s[2] * rstd * w0.z, s[3] * rstd * w0.w);
        o.z = pk2(s[4] * rstd * w1.x, s[5] * rstd * w1.y); o.w = pk2(s[6] * rstd * w1.z, s[7] * rstd * w1.w);
        *(v4u*)(MIXIN + (size_t)row * DM + 512 + lane * 8) = o;
    }
}

__device__ __forceinline__ void ph_mid(const int wv_, const Params& p, LAS unsigned char* lds) {
    const int tid = otid(), lane = tid & 63, wave = tid >> 6;
    LAS float* gs = (LAS float*)lds + 1024; LAS float* sh = gs + 1024; LAS int* cnt = (LAS int*)(sh + 1024);
    LAS float* lg = (LAS float*)(lds + 16384) + wave * (16 * 33);
    unsigned char* H8 = p.ws + WS_H8;
    const bf16* RWT = (const bf16*)(p.ws + WS_RWT); const float* rb = p.in[28];
    int* TOPI = (int*)(p.ws + WS_TOPI); float* GATE = (float*)(p.ws + WS_GATE); int* CNT = (int*)(p.ws + WS_CNT);
    for (int chunk = blockIdx.x; chunk < NTOK / 128; chunk += gridDim.x) {
        const int b = chunk / (SEQ / 128);
        { const float* modf = (const float*)(p.ws + WS_MODF) + (size_t)b * 6144; for (int j = tid; j < 1024; j += 512) { gs[j] = p.in[26][j] * (1.0f + modf[4096 + j]); sh[j] = modf[3072 + j]; } }
        if (tid < 32) cnt[tid] = 0;
        __syncthreads();
        const int row0 = chunk * 128 + wave * 16;
        const bf16* XM = (const bf16*)(p.ws + WS_XMID); const float* PARTX = (const float*)(p.ws + WS_PARTX);
        {
            const int rr = lane & 15, kq = lane >> 4; const int row = row0 + rr;
            float rstd;
            { const f32x4* px = (const f32x4*)(PARTX + (size_t)row * 16); const f32x4 p0 = px[0], p1 = px[1], p2 = px[2], p3 = px[3];
              const f32x4 ps = (p0 + p1) + (p2 + p3); rstd = rsqrtf(((ps.x + ps.y) + (ps.z + ps.w)) * (1.0f / DM) + RMS_EPS); }
            const bf16* xp = XM + (size_t)row * DM + kq * 8; unsigned char* h8p = H8 + (size_t)row * DM + kq * 8;
            const bf16* bp = RWT + (size_t)rr * DM + kq * 8; const LAS float* gp = gs + kq * 8; const LAS float* sp = sh + kq * 8;
            f32x4 a0 = {0.f, 0.f, 0.f, 0.f}, a1 = {0.f, 0.f, 0.f, 0.f};
#pragma unroll 8
            for (int ks = 0; ks < 32; ++ks) {
                const v4u xw = __builtin_nontemporal_load((const v4u*)(xp + ks * 32));
                const bf16x8 b0 = *(const bf16x8*)(bp + ks * 32), b1 = *(const bf16x8*)(bp + 16 * DM + ks * 32);
                const f32x4 g0 = *(const LAS f32x4*)(gp + ks * 32), g1 = *(const LAS f32x4*)(gp + ks * 32 + 4), s0 = *(const LAS f32x4*)(sp + ks * 32), s1 = *(const LAS f32x4*)(sp + ks * 32 + 4);
                const float h0 = bflo(xw.x) * rstd * g0.x + s0.x, h1 = bfhi(xw.x) * rstd * g0.y + s0.y, h2v = bflo(xw.y) * rstd * g0.z + s0.z, h3 = bfhi(xw.y) * rstd * g0.w + s0.w;
                const float h4 = bflo(xw.z) * rstd * g1.x + s1.x, h5 = bfhi(xw.z) * rstd * g1.y + s1.y, h6 = bflo(xw.w) * rstd * g1.z + s1.z, h7 = bfhi(xw.w) * rstd * g1.w + s1.w;
                const v4u hw = {pk2(h0, h1), pk2(h2v, h3), pk2(h4, h5), pk2(h6, h7)}; const bf16x8 af = __builtin_bit_cast(bf16x8, hw);
                v2u o8; o8.x = pg8::pk4_fp8(h0, h1, h2v, h3); o8.y = pg8::pk4_fp8(h4, h5, h6, h7); *(v2u*)(h8p + ks * 32) = o8;
                a0 = __builtin_amdgcn_mfma_f32_16x16x32_bf16(af, b0, a0, 0, 0, 0); a1 = __builtin_amdgcn_mfma_f32_16x16x32_bf16(af, b1, a1, 0, 0, 0); }
            const float rb0 = rb[rr], rb1 = rb[16 + rr];
#pragma unroll
            for (int rg = 0; rg < 4; ++rg) { lg[(4 * kq + rg) * 33 + rr] = a0[rg] + rb0; lg[(4 * kq + rg) * 33 + 16 + rr] = a1[rg] + rb1; }
        }
        LDS_WAIT(); asm volatile("" ::: "memory");
        if (lane < 16) {
            float l[32];
#pragma unroll
            for (int e = 0; e < 32; ++e) l[e] = lg[lane * 33 + e];
            int ti[4]; float tv[4];
#pragma unroll
            for (int k = 0; k < 4; ++k) { float best = -3.0e38f; int bi = 0;
#pragma unroll
                for (int e = 0; e < 32; ++e) { const bool take = l[e] > best; best = take ? l[e] : best; bi = take ? e : bi; }
                ti[k] = bi; tv[k] = best;
#pragma unroll
                for (int e = 0; e < 32; ++e) l[e] = (e == bi) ? -3.0e38f : l[e]; }
            const float e1 = __expf(tv[1] - tv[0]), e2 = __expf(tv[2] - tv[0]), e3 = __expf(tv[3] - tv[0]); const float inv = 1.0f / (1.0f + e1 + e2 + e3);
            const int row = row0 + lane;
            *(int4*)(TOPI + (size_t)row * 4) = make_int4(ti[0], ti[1], ti[2], ti[3]); *(f32x4*)(GATE + (size_t)row * 4) = (f32x4){inv, e1 * inv, e2 * inv, e3 * inv};
            atomicAdd((int*)(cnt + ti[0]), 1); atomicAdd((int*)(cnt + ti[1]), 1); atomicAdd((int*)(cnt + ti[2]), 1); atomicAdd((int*)(cnt + ti[3]), 1);
        }
        __syncthreads();
        if (tid < 32) CNT[chunk * 32 + tid] = cnt[tid];
        __syncthreads();
    }
}

__device__ __forceinline__ void ph_scatter(const int wv_, const Params& p, LAS unsigned char* lds) {
    const int tid = otid(), lane = tid & 63, wave = tid >> 6;
    LAS int* tot = (LAS int*)lds; LAS int* pst = tot + 32; LAS int* cur = pst + 32; LAS int* rowof = cur + 32  ; LAS int* pre = rowof + 512;
    const int* CNT = (const int*)(p.ws + WS_CNT); const int* TOPI = (const int*)(p.ws + WS_TOPI); const float* GATE = (const float*)(p.ws + WS_GATE);
    int* DEST = (int*)(p.ws + WS_DEST); int* ROWTOK = (int*)(p.ws + WS_ROWTOK); float* ROWGATE = (float*)(p.ws + WS_ROWGATE);
    int* BLKE = (int*)(p.ws + WS_BLKE); int* NRB = (int*)(p.ws + WS_NRB);
    const unsigned char* H8 = p.ws + WS_H8; unsigned char* XS8 = p.ws + WS_XS8;
    for (int chunk = blockIdx.x; chunk < NTOK / 128; chunk += gridDim.x) {
        {
          LAS int* ptl = pre + 32; const int e_ = tid & 31, cg = tid >> 5; int t = 0, pr = 0;
#pragma unroll
          for (int k = 0; k < 16; ++k) { const int c = cg * 16 + k; const int v = CNT[c * 32 + e_]; t += v; pr += (c < chunk) ? v : 0; }
          ptl[cg * 32 + e_] = t; ptl[512 + cg * 32 + e_] = pr;
          __syncthreads();
          if (tid < 32) { int ts = 0, ps = 0;
#pragma unroll
              for (int k = 0; k < 16; ++k) { ts += ptl[k * 32 + tid]; ps += ptl[512 + k * 32 + tid]; }
              tot[tid] = ts; pre[tid] = ps; } }
        __syncthreads();
        if (tid < 32) {
            int acc = 0, all = 0;
#pragma unroll
            for (int k = 0; k < 32; ++k) { const int pk = ((tot[k] + 255) >> 8) << 8; acc += (k < tid) ? pk : 0; all += pk; }
            pst[tid] = acc; cur[tid] = acc + pre[tid];
            if (chunk == 0 && tid == 0) NRB[0] = all >> 8; }
        __syncthreads();
        if (chunk == 0) {
            const int nrb = (pst[31] + (((tot[31] + 255) >> 8) << 8)) >> 8;
            for (int rb = tid; rb < MAXRB; rb += 512) { int e = 31; for (int k = 0; k < 32; ++k) { if (rb * 256 < pst[k] + (((tot[k] + 255) >> 8) << 8)) { e = k; break; } } BLKE[rb] = (rb < nrb) ? e : 31; }
        }
        if (chunk < 32) {
            const int e = chunk, r0 = pst[e] + tot[e], r1 = pst[e] + (((tot[e] + 255) >> 8) << 8);
            for (int r = r0 + wave; r < r1; r += 8) { v4u z = {0u, 0u, 0u, 0u}; v4u* dst = (v4u*)(XS8 + (size_t)r * DM); dst[lane] = z; if (lane == 0) { ROWTOK[r] = -1; ROWGATE[r] = 0.f; } }
        }
        { const int tok = chunk * 128 + (tid >> 2), k = tid & 3; const int e = TOPI[tok * 4 + k];
          LAS int* wc = pre + 32;
          int rank = 0, mycnt = 0;
#pragma unroll 4
          for (int x = 0; x < 32; ++x) { const unsigned long long m = __ballot(e == x);
              const int below = (int)__builtin_amdgcn_mbcnt_hi((unsigned)(m >> 32), __builtin_amdgcn_mbcnt_lo((unsigned)m, 0u));
              rank = (e == x) ? below : rank; mycnt = (lane == x) ? (int)__popcll(m) : mycnt; }
          __syncthreads();
          if (lane < 32) wc[wave * 32 + lane] = mycnt;
          __syncthreads();
          int base = 0;
#pragma unroll
          for (int w2 = 0; w2 < 8; ++w2) base += (w2 < wave) ? wc[w2 * 32 + e] : 0;
          const int row = cur[e] + base + rank;
          DEST[tok * 4 + k] = row; ROWTOK[row] = tok; ROWGATE[row] = GATE[tok * 4 + k]; rowof[tid] = row; }
        __syncthreads();
        for (int a = wave * 64; a < wave * 64 + 64; ++a) { const int row = rowof[a], tok = chunk * 128 + (a >> 2);
            const v4u* src = (const v4u*)(H8 + (size_t)tok * DM); v4u* dst = (v4u*)(XS8 + (size_t)row * DM);
            dst[lane] = src[lane]; }
        __syncthreads();
    }
}

typedef float f32x2u __attribute__((ext_vector_type(2)));
__device__ __forceinline__ void ph_combine(const int wv_, const Params& p, LAS unsigned char* lds) {
    const int tid = otid(), lane = tid & 63, wave = tid >> 6;
    LAS float* g2 = (LAS float*)lds;
    const unsigned char* YS = p.ws + WS_YS; const int* DEST = (const int*)(p.ws + WS_DEST);
    for (int chunk = blockIdx.x; chunk < NTOK / 128; chunk += gridDim.x) {
        const int b = chunk / (SEQ / 128);
        for (int j = tid; j < 1024; j += 512) g2[j] = ((const float*)(p.ws + WS_MODF))[(size_t)b * 6144 + 5120 + j] * (1.0f / YSCALE);
        __syncthreads();
        const int rowb = chunk * 128 + wave * 16;
        unsigned yn[4][4]; v2u on[4]; int4 dn;
        { const int4 d4 = *(const int4*)(DEST + (size_t)rowb * 4); const int dd[4] = {d4.x, d4.y, d4.z, d4.w};
#pragma unroll
          for (int k = 0; k < 4; ++k) { const unsigned* yp = (const unsigned*)(YS + (size_t)dd[k] * DM) + lane;
#pragma unroll
              for (int j = 0; j < 4; ++j) yn[k][j] = __builtin_nontemporal_load(yp + 64 * j); }
          const v2u* orow = (const v2u*)((const bf16*)(p.ws + WS_XMID) + (size_t)rowb * DM) + lane;
#pragma unroll
          for (int j = 0; j < 4; ++j) on[j] = __builtin_nontemporal_load(orow + 64 * j);
          dn = *(const int4*)(DEST + (size_t)(rowb + 1) * 4); }
        for (int i = 0; i < 16; ++i) { const int row = rowb + i;
            unsigned yv[4][4]; v2u ov[4];
#pragma unroll
            for (int k = 0; k < 4; ++k)
#pragma unroll
                for (int j = 0; j < 4; ++j) yv[k][j] = yn[k][j];
#pragma unroll
            for (int j = 0; j < 4; ++j) ov[j] = on[j];
            { const int rn = row + (i < 15 ? 1 : 0); const int dd[4] = {dn.x, dn.y, dn.z, dn.w};
#pragma unroll
              for (int k = 0; k < 4; ++k) { const unsigned* yp = (const unsigned*)(YS + (size_t)dd[k] * DM) + lane;
#pragma unroll
                  for (int j = 0; j < 4; ++j) yn[k][j] = __builtin_nontemporal_load(yp + 64 * j); }
              const v2u* orn = (const v2u*)((const bf16*)(p.ws + WS_XMID) + (size_t)rn * DM) + lane;
#pragma unroll
              for (int j = 0; j < 4; ++j) on[j] = __builtin_nontemporal_load(orn + 64 * j);
              dn = *(const int4*)(DEST + (size_t)(row + (i < 14 ? 2 : (i < 15 ? 1 : 0))) * 4); }
            f32x4* orow = (f32x4*)(p.out + (size_t)row * DM) + lane;
#pragma unroll
            for (int j = 0; j < 4; ++j) { const int c0 = 4 * lane + 256 * j; const f32x4 gg = *(const LAS f32x4*)(g2 + c0);
                f32x2u lo = {0.f, 0.f}, hi = {0.f, 0.f};
#pragma unroll
                for (int k = 0; k < 4; ++k) { lo += __builtin_amdgcn_cvt_pk_f32_fp8((int)yv[k][j], false); hi += __builtin_amdgcn_cvt_pk_f32_fp8((int)yv[k][j], true); }
                f32x4 v = {bflo(ov[j].x), bfhi(ov[j].x), bflo(ov[j].y), bfhi(ov[j].y)}; v.x += gg.x * lo.x; v.y += gg.y * lo.y; v.z += gg.z * hi.x; v.w += gg.w * hi.y;
                __builtin_nontemporal_store(v, orow + 64 * j); }
        }
        __syncthreads();
    }
}

constexpr int N_PHASES = 15;
__global__ void __launch_bounds__(512, 2) fwd_kernel(Params p) {
    extern __shared__ __attribute__((aligned(16))) unsigned char lds_raw[];
    LAS unsigned char* lds = (LAS unsigned char*)lds_raw;
    const int wv_ = __builtin_amdgcn_readfirstlane(threadIdx.x >> 6);
    const int tid = otid();
    unsigned char* ws = p.ws;
    for (int u = tid; u < (LDS_BYTES - LDSCTL_OFF) / 4; u += 512) ((LAS unsigned*)(lds + LDSCTL_OFF))[u] = 0u;
    __syncthreads();
    const int lo = p.ph_lo, hi = p.ph_hi;
    XcdBarrier bar; bar.bar = (unsigned*)(ws + WS_CTL) + CW_BAR + p.li * XCD_BAR_WORDS; bar.x = 0; bar.st = nullptr;
    if (hi - lo > 1) bar = xcd_barrier_post(wv_, (unsigned*)(ws + WS_CTL) + CW_BAR + p.li * XCD_BAR_WORDS, (volatile LAS unsigned*)(lds + MISC_OFF) + 8);
#define IN(k) (lo <= (k) && (k) < hi)
#define SEAM(k) do { if (IN(k) && IN((k) + 1)) xcd_barrier(wv_, bar); } while (0)
#define SEAM2(k, k2) do { if (IN(k) && IN(k2)) xcd_barrier(wv_, bar); } while (0)

    if (IN(0)) { ph_prologue(wv_, p, lds); } SEAM(0);
    if (IN(1)) { ph_norm1(wv_, p, lds); } SEAM(1);
    if (IN(2)) {
        pg8::DenseSched S; S.o.init(NTOK / 256, NPROJ / 256, gridDim.x, blockIdx.x); S.A = (const char*)(ws + WS_H8); S.Bt = (const char*)(ws + WS_WINT); S.sideP = nullptr; S.side = nullptr; S.wv = wv_;
        pg8::EpiProj E{(pg8::bf16_t*)(ws + WS_QG), (pg8::bf16_t*)(ws + WS_KG), (pg8::bf16_t*)(ws + WS_VTG), (pg8::bf16_t*)(ws + WS_UG), p.in[7], p.in[8], (const float*)(ws + WS_CS), ATT_QK_INV, 1.0f / WSCALE};
        pg8::gemm_phase<pg8::EpiProj, pg8::DenseSched, true, true, true>(wv_, lds + RING_OFF, 512, S, E);
    } SEAM2(2, 4);
    {
        const int n_att = (NB * NHEAD * (SEQ / 256) + gridDim.x - 1) / gridDim.x, k_s5 = (int)((blockIdx.x >> 3) % (unsigned)(n_att + 1));
        for (int part = 0; part < 2; ++part) {
            if (IN(4)) ph_attn(wv_, p, lds, part == 0 ? 0 : k_s5, part == 0 ? k_s5 : n_att);
            if (part == 0 && IN(5)) { __syncthreads(); ph_s5(wv_, p, lds); __syncthreads(); }
        }
    }
    if ((IN(4) || IN(5)) && IN(6)) xcd_barrier(wv_, bar);
    if (IN(6)) { ph_s5_gelu(wv_, p); } SEAM(6);
    if (IN(7)) {
        pg8::DenseSched S; S.o.init(NTOK / 256, WS5 / 256, gridDim.x, blockIdx.x); S.A = (const char*)(ws + WS_YSPRE); S.Bt = (const char*)(ws + WS_GLUT); S.sideP = nullptr; S.side = nullptr; S.wv = wv_;
        pg8::EpiGlu E{(const pg8::bf16_t*)(ws + WS_YSPRE), p.in[23], (pg8::bf16_t*)(ws + WS_MIXIN), (float*)(ws + WS_PARTS)};
        pg8::gemm_phase<pg8::EpiGlu, pg8::DenseSched, true, true>(wv_, lds + RING_OFF, 512, S, E);
    } SEAM2(7, 9);
    if (IN(9)) {
        pg8::DenseSched S; S.o.init(NTOK / 256, DM / 256, gridDim.x, blockIdx.x); S.A = (const char*)(ws + WS_MIXIN); S.Bt = (const char*)(ws + WS_WOUTT); S.sideP = (const float*)(ws + WS_PARTS); S.side = lds + LDSCTL_OFF + 4096; S.wv = wv_;
        pg8::EpiXmid E{p.in[0], (const float*)(ws + WS_MODF) + 2048, (pg8::bf16_t*)(ws + WS_XMID), (float*)(ws + WS_PARTX), lds + LDSCTL_OFF + 4096};
        pg8::gemm_phase<pg8::EpiXmid, pg8::DenseSched, true, true>(wv_, lds + RING_OFF, 1024, S, E);
    } SEAM(9);
    if (IN(10)) { ph_mid(wv_, p, lds); } SEAM(10);
    if (IN(11)) { ph_scatter(wv_, p, lds); } SEAM(11);
    if (IN(12)) {
        const int nrb = __builtin_amdgcn_readfirstlane(*(const int*)(ws + WS_NRB));
        LAS int* ble = (LAS int*)(lds + LDSCTL_OFF + 2048); for (int j = otid(); j < MAXRB; j += 512) ble[j] = ((const int*)(ws + WS_BLKE))[j]; pg8::swiglu_table_fill(lds, otid()); __syncthreads();
        pg8::GroupSched S; S.o.init(nrb, 2048 / 256, gridDim.x, blockIdx.x); S.A = (const char*)(ws + WS_XS8); S.W = (const char*)(ws + WS_W1T8); S.estride = (size_t)2048 * 1024; S.block_e = ble;
        S.bias = p.in[30]; S.bias_ld = 2048; S.rowgate = nullptr; S.side = lds + LDSCTL_OFF + 8192; S.wv = wv_;
        pg8::EpiSwiglu8 E{ws + WS_ACT8, lds + LDSCTL_OFF + 8192, 1.0f / WSCALE};
        static_assert(LDSCTL_OFF + 8192 == pg8::SWG_SIDE_OFF && LDSCTL_OFF + 12288 == pg8::SWG_TAB_OFF && pg8::SWG_TAB_OFF + 4 * pg8::SWG_TAB_N <= LDS_BYTES, "SwiGLU table placement");
        pg8::gemm_phase<pg8::EpiSwiglu8, pg8::GroupSched, true, true, true>(wv_, lds + RING_OFF, 512, S, E);
    } SEAM(12);
    if (IN(13)) {
        const int nrb = __builtin_amdgcn_readfirstlane(*(const int*)(ws + WS_NRB));
        LAS int* ble = (LAS int*)(lds + LDSCTL_OFF + 2048); for (int j = otid(); j < MAXRB; j += 512) ble[j] = ((const int*)(ws + WS_BLKE))[j]; __syncthreads();
        pg8::GroupSched S; S.o.init(nrb, 1024 / 256, gridDim.x, blockIdx.x); S.A = (const char*)(ws + WS_ACT8); S.W = (const char*)(ws + WS_W2T8); S.estride = (size_t)1024 * 1024; S.block_e = ble;
        S.bias = p.in[32]; S.bias_ld = 1024; S.rowgate = (const float*)(ws + WS_ROWGATE); S.side = lds + LDSCTL_OFF + 8192; S.wv = wv_;
        pg8::EpiRowScale E{ws + WS_YS, lds + LDSCTL_OFF + 8192, 1.0f / WSCALE, YSCALE};
        pg8::gemm_phase<pg8::EpiRowScale, pg8::GroupSched, true, true, true>(wv_, lds + RING_OFF, 512, S, E);
    } SEAM(13);
    if (IN(14)) { ph_combine(wv_, p, lds); }
#undef IN
#undef SEAM
}

extern "C" void kernel_launch(void* const* d_in, const int* in_sizes, int n_in, void* d_out, int out_size, void* d_ws, size_t ws_size, hipStream_t stream) {
    static int grid = 0;
    if (grid == 0) {
        if (n_in != 33 || out_size != NTOK * DM || ws_size < WS_END) { fprintf(stderr, "kernel_launch: unexpected shapes (n_in %d out %d ws %zu)\n", n_in, out_size, ws_size); grid = -1; return; }
        int dev = 0, cus = 0, per_cu = 0;
        if (hipGetDevice(&dev) != hipSuccess || hipDeviceGetAttribute(&cus, hipDeviceAttributeMultiprocessorCount, dev) != hipSuccess) { grid = -1; return; }
        if (hipFuncSetAttribute((const void*)fwd_kernel, hipFuncAttributeMaxDynamicSharedMemorySize, LDS_BYTES) != hipSuccess) { fprintf(stderr, "kernel_launch: hipFuncSetAttribute failed\n"); grid = -1; return; }
        if (hipOccupancyMaxActiveBlocksPerMultiprocessor(&per_cu, (const void*)fwd_kernel, 512, LDS_BYTES) != hipSuccess || per_cu < 1) fprintf(stderr, "kernel_launch: occupancy query says %d\n", per_cu);
        (void)hipGetLastError();
        grid = cus;
    }
    if (grid < 0) return;
    if (hipMemsetAsync((char*)d_ws + WS_CTL, 0, CTL_ZERO_BYTES, stream) != hipSuccess) return;
    Params a{};
    for (int i = 0; i < 33; ++i) a.in[i] = (const float*)d_in[i];
    a.out = (float*)d_out; a.ws = (unsigned char*)d_ws;
#ifdef PROBE_REP
    a.ph_lo = 0; a.ph_hi = PROBE_REP + 1; a.li = 0; hipLaunchKernelGGL(fwd_kernel, dim3(grid), dim3(512), LDS_BYTES, stream, a);
    a.ph_lo = PROBE_REP; a.ph_hi = PROBE_REP + 1; a.li = 1; hipLaunchKernelGGL(fwd_kernel, dim3(grid), dim3(512), LDS_BYTES, stream, a);
    if (PROBE_REP + 1 < N_PHASES) { a.ph_lo = PROBE_REP + 1; a.ph_hi = N_PHASES; a.li = 2; hipLaunchKernelGGL(fwd_kernel, dim3(grid), dim3(512), LDS_BYTES, stream, a); }
#else
    a.ph_lo = 0; a.ph_hi = N_PHASES; a.li = 0; hipLaunchKernelGGL(fwd_kernel, dim3(grid), dim3(512), LDS_BYTES, stream, a);
#endif
}
```
